# Optimizing an MI355X kernel written in HIP

```python
import functools
import jax, jax.numpy as jnp
from jax import lax
import numpy as np

D_MODEL = 1024
BATCH = 2
SEQ = 8192
DEPTH = 2
DEC_BATCH = 128
DEC_SEQ = 1
PAST_LEN = 2048
PAGE_SIZE = 128

D_MIX = D_MODEL
NSA_WIDTH = D_MIX // 2
NSA_HD = 64
NSA_HEADS = NSA_WIDTH // NSA_HD
NSA_KV_HEADS = 2
NSA_GROUP = NSA_HEADS // NSA_KV_HEADS
CMP_BLOCK = 32
CMP_STRIDE = 16
CMP_RATIO = CMP_BLOCK // CMP_STRIDE
CMP_HIDDEN = 2 * NSA_HD
SEL_BLOCK = 64
SEL_TOPK = 16
WINDOW = 512
Q_BLOCK = 128
FORCE_BONUS = 1000.0
GLA_WIDTH = D_MIX - NSA_WIDTH
GLA_HEADS = 4
GLA_DV = GLA_WIDTH // GLA_HEADS
GLA_DK = GLA_DV // 2
GLA_RANK = 16
GLA_TAU = 16.0
GLA_CHUNK = 64
FFN_DIM = 2816
N_MOD = 9
EPS = 1e-6
KV_COLS = 2 * NSA_KV_HEADS * NSA_HD
IN_SIZES = (NSA_WIDTH, KV_COLS, KV_COLS, KV_COLS, 3 * NSA_HEADS,
            GLA_HEADS * GLA_DK, GLA_HEADS * GLA_DK, GLA_WIDTH, GLA_RANK, GLA_WIDTH)
IN_COLS = sum(IN_SIZES)

kernel_name = 'hybrid_nsa_gla_macaron_adaln_step'


def rms_norm(x, g):
    xf = x.astype(jnp.float32)
    y = xf * lax.rsqrt(jnp.mean(xf * xf, axis=-1, keepdims=True) + EPS)
    return (y * g.astype(jnp.float32)).astype(x.dtype)


def alibi_slopes(n):
    return jnp.asarray(np.exp2(-8.0 * np.arange(1, n + 1) / n), dtype=jnp.float32)


def masked_softmax(logits, mask):
    m = jnp.max(jnp.where(mask, logits, -jnp.inf), axis=-1, keepdims=True)
    m = jnp.where(jnp.isfinite(m), m, 0.0)
    e = jnp.where(mask, jnp.exp(logits - m), 0.0)
    return e / jnp.maximum(jnp.sum(e, axis=-1, keepdims=True), 1e-30)


def swiglu(h, w_in, w_out):
    g, u = jnp.split(jnp.einsum('btd,df->btf', h, w_in), 2, axis=-1)
    return jnp.einsum('btf,fd->btd', jax.nn.silu(g) * u, w_out)


def compress(x, pe, w1, b1, w2):
    b, t, g, hd = x.shape
    n_chunks = -(-t // CMP_STRIDE)
    x = jnp.pad(x, ((0, 0), (0, n_chunks * CMP_STRIDE - t), (0, 0), (0, 0)))
    ch = x.reshape(b, n_chunks, CMP_STRIDE, g, hd)
    nc = n_chunks - CMP_RATIO + 1
    pe_r = pe.reshape(CMP_RATIO, CMP_STRIDE, hd)
    w1_r = w1.reshape(CMP_RATIO, CMP_STRIDE, hd, CMP_HIDDEN)
    h = b1
    for r in range(CMP_RATIO):
        h = h + jnp.einsum('bnsgd,sdh->bngh', ch[:, r:r + nc] + pe_r[r][:, None, :], w1_r[r])
    return jnp.einsum('bngh,hd->bngd', jax.nn.gelu(h), w2)


def sel_blocks(x):
    b, t, g, hd = x.shape
    ns = -(-t // SEL_BLOCK)
    x = jnp.pad(x, ((0, 0), (0, ns * SEL_BLOCK - t), (0, 0), (0, 0)))
    return x.reshape(b, ns, SEL_BLOCK, g, hd).transpose(0, 3, 1, 2, 4)


def nsa_core(q, gates, t_pos, ck, cv, sk, sv, wk, wv, w_pos, slopes):
    b, nq = q.shape[:2]
    G, R = NSA_KV_HEADS, NSA_GROUP
    qg = q.reshape(b, nq, G, R, NSA_HD) * (NSA_HD ** -0.5)
    sl5 = slopes.reshape(G, R)[None, :, :, None, None]
    nc = ck.shape[1]
    c_start = jnp.arange(nc) * CMP_STRIDE
    c_end = c_start + (CMP_BLOCK - 1)
    dist_c = t_pos[:, None] - c_end[None, :]
    lc = jnp.einsum('bqgrd,bcgd->bgrqc', qg, ck).astype(jnp.float32)
    pc = masked_softmax(lc - sl5 * dist_c.astype(jnp.float32), dist_c >= 0)
    o_cmp = jnp.einsum('bgrqc,bcgd->bqgrd', pc.astype(cv.dtype), cv)
    ns = sk.shape[2]
    s_start = jnp.arange(ns) * SEL_BLOCK
    overlap = ((c_start[:, None] <= s_start[None, :] + SEL_BLOCK - 1)
               & (c_end[:, None] >= s_start[None, :])).astype(jnp.float32)
    imp = jnp.einsum('bgrqc,cs->bgqs', pc, overlap)
    cur = t_pos // SEL_BLOCK
    blk = jnp.arange(ns)
    forced = (blk[None, :] == 0) | (blk[None, :] == cur[:, None]) | (blk[None, :] == cur[:, None] - 1)
    valid = s_start[None, :] <= t_pos[:, None]
    score = jnp.where(valid, imp + jnp.where(forced, FORCE_BONUS, 0.0), -1e30)
    n_sel = min(SEL_TOPK, ns)
    _, idx = lax.top_k(score, n_sel)
    gather = jax.vmap(jax.vmap(lambda blocks, ids: blocks[ids]))
    kg = gather(sk, idx)
    vg = gather(sv, idx)
    s_pos = idx[..., None] * SEL_BLOCK + jnp.arange(SEL_BLOCK)
    dist_s = t_pos[None, None, :, None, None] - s_pos
    ls = jnp.einsum('bqgrd,bgqksd->bgrqks', qg, kg).astype(jnp.float32)
    ls = ls - slopes.reshape(G, R)[None, :, :, None, None, None] * dist_s[:, :, None].astype(jnp.float32)
    nk = n_sel * SEL_BLOCK
    ps = masked_softmax(ls.reshape(b, G, R, nq, nk), (dist_s >= 0)[:, :, None].reshape(b, G, 1, nq, nk))
    o_slc = jnp.einsum('bgrqn,bgqnd->bqgrd', ps.astype(vg.dtype), vg.reshape(b, G, nq, nk, NSA_HD))
    dist_w = t_pos[:, None] - w_pos[None, :]
    mask_w = (dist_w >= 0) & (dist_w < WINDOW) & (w_pos[None, :] >= 0)
    lw = jnp.einsum('bqgrd,bwgd->bgrqw', qg, wk).astype(jnp.float32)
    pw = masked_softmax(lw - sl5 * dist_w.astype(jnp.float32), mask_w)
    o_win = jnp.einsum('bgrqw,bwgd->bqgrd', pw.astype(wv.dtype), wv)
    gg = gates.reshape(b, nq, G, R, 3)
    o = gg[..., 0:1] * o_cmp + gg[..., 1:2] * o_slc + gg[..., 2:3] * o_win
    return o.reshape(b, nq, NSA_WIDTH)


def nsa_prompt(q, gates, kv_c, kv_s, kv_w, cmp, slopes):
    pe, w1, b1, w2 = cmp
    b, t = q.shape[:2]
    ck = compress(kv_c[:, :, 0], pe[0], w1[0], b1[0], w2[0])
    cv = compress(kv_c[:, :, 1], pe[1], w1[1], b1[1], w2[1])
    sk = sel_blocks(kv_s[:, :, 0])
    sv = sel_blocks(kv_s[:, :, 1])
    wkv = jnp.pad(kv_w, ((0, 0), (WINDOW, 0), (0, 0), (0, 0), (0, 0)))
    nqb = t // Q_BLOCK
    qb = q.reshape(b, nqb, Q_BLOCK, NSA_HEADS, NSA_HD).swapaxes(0, 1)
    gb = gates.reshape(b, nqb, Q_BLOCK, NSA_HEADS, 3).swapaxes(0, 1)

    def step(args):
        qi, gi, i = args
        start = i * Q_BLOCK
        t_pos = start + jnp.arange(Q_BLOCK)
        wi = lax.dynamic_slice_in_dim(wkv, start, WINDOW + Q_BLOCK, axis=1)
        w_pos = start - WINDOW + jnp.arange(WINDOW + Q_BLOCK)
        return nsa_core(qi, gi, t_pos, ck, cv, sk, sv, wi[:, :, 0], wi[:, :, 1], w_pos, slopes)

    o = lax.map(step, (qb, gb, jnp.arange(nqb)))
    return o.swapaxes(0, 1).reshape(b, t, NSA_WIDTH)


def nsa_sample(q, gates, kv_c, kv_s, kv_w, cmp, slopes, cache_c, cache_s, cache_w, page_table):
    pe, w1, b1, w2 = cmp
    nb, ns_new = q.shape[:2]
    past = page_table.shape[1] * cache_c.shape[1]
    wl = cache_w.shape[1]

    def gather_pages(cache):
        return cache[page_table].reshape(nb, past, 2, NSA_KV_HEADS, NSA_HD)

    full_c = jnp.concatenate([gather_pages(cache_c), kv_c], axis=1)
    full_s = jnp.concatenate([gather_pages(cache_s), kv_s], axis=1)
    win = jnp.concatenate([cache_w, kv_w], axis=1)
    ck = compress(full_c[:, :, 0], pe[0], w1[0], b1[0], w2[0])
    cv = compress(full_c[:, :, 1], pe[1], w1[1], b1[1], w2[1])
    sk = sel_blocks(full_s[:, :, 0])
    sv = sel_blocks(full_s[:, :, 1])
    t_pos = past + jnp.arange(ns_new)
    w_pos = past - wl + jnp.arange(wl + ns_new)
    return nsa_core(q, gates, t_pos, ck, cv, sk, sv, win[:, :, 0], win[:, :, 1], w_pos, slopes)


def gla_chunk(q, k, v, log_a, s0):
    c = q.shape[2]
    cum = jnp.cumsum(log_a, axis=2)
    causal = jnp.tril(jnp.ones((c, c), dtype=bool))
    diff = cum[:, :, :, None, :] - cum[:, :, None, :, :]
    decay = jnp.exp(jnp.where(causal[:, :, None], diff, -jnp.inf))
    attn = jnp.einsum('bhtd,bhsd,bhtsd->bhts', q, k, decay)
    o = jnp.einsum('bhtd,bhde->bhte', q * jnp.exp(cum), s0) + jnp.einsum('bhts,bhse->bhte', attn, v)
    last = cum[:, :, -1:, :]
    s_new = jnp.exp(last[:, :, 0, :, None]) * s0 + jnp.einsum('bhsd,bhse->bhde', k * jnp.exp(last - cum), v)
    return o, s_new


def gla_prompt(q, k, v, log_a):
    b, t = q.shape[:2]
    n = t // GLA_CHUNK

    def chunks(z):
        return z.astype(jnp.float32).reshape(b, n, GLA_CHUNK, GLA_HEADS, z.shape[-1]).transpose(1, 0, 3, 2, 4)

    def step(s, inp):
        o, s = gla_chunk(inp[0], inp[1], inp[2], inp[3], s)
        return s, o

    s0 = jnp.zeros((b, GLA_HEADS, GLA_DK, GLA_DV), jnp.float32)
    s_fin, o = lax.scan(step, s0, (chunks(q), chunks(k), chunks(v), chunks(log_a)))
    return o.transpose(1, 0, 3, 2, 4).reshape(b, t, GLA_HEADS, GLA_DV), s_fin


def mix_prompt(q_n, g_n, kv_c, kv_s, kv_w, q_g, k_g, v_g, log_a, cmp, slopes):
    t = q_n.shape[1]
    o_nsa = nsa_prompt(q_n, g_n, kv_c, kv_s, kv_w, cmp, slopes)
    o_gla, s_fin = gla_prompt(q_g, k_g, v_g, log_a)
    return o_nsa, o_gla.astype(q_n.dtype), (kv_c, kv_s, kv_w[:, t - min(WINDOW, t):], s_fin)


def mix_sample(q_n, g_n, kv_c, kv_s, kv_w, q_g, k_g, v_g, log_a, cmp, slopes,
               cache_c, cache_s, cache_w, state, page_table):
    o_nsa = nsa_sample(q_n, g_n, kv_c, kv_s, kv_w, cmp, slopes, cache_c, cache_s, cache_w, page_table)

    def heads_first(z):
        return z.astype(jnp.float32).transpose(0, 2, 1, 3)

    o, s_new = gla_chunk(heads_first(q_g), heads_first(k_g), heads_first(v_g), heads_first(log_a),
                         state.astype(jnp.float32))
    return o_nsa, o.transpose(0, 2, 1, 3).astype(q_n.dtype), (kv_c, kv_s, kv_w, s_new)


def trunk_layer(x, c, mix_fn, w_ada, b_ada, norm_g, f1_in, f1_out, w_in, gla_wa2, gla_ba, gla_norm,
                w_out, f2_in, f2_out):
    b, t, _ = x.shape
    mod = (jnp.einsum('bd,de->be', jax.nn.silu(c), w_ada) + b_ada).reshape(b, 1, N_MOD, D_MODEL)
    h = rms_norm(x, norm_g[0]) * (1.0 + mod[:, :, 1]) + mod[:, :, 0]
    x = x + 0.5 * mod[:, :, 2] * swiglu(h, f1_in, f1_out)
    h = rms_norm(x, norm_g[1]) * (1.0 + mod[:, :, 4]) + mod[:, :, 3]
    p = jnp.einsum('btd,de->bte', h, w_in)
    offsets = np.cumsum(IN_SIZES)[:-1].tolist()
    q_n, kv_c, kv_s, kv_w, g_n, q_g, k_g, v_g, a_g, o_g = jnp.split(p, offsets, axis=-1)
    q_n = q_n.reshape(b, t, NSA_HEADS, NSA_HD)
    kv_c = kv_c.reshape(b, t, 2, NSA_KV_HEADS, NSA_HD)
    kv_s = kv_s.reshape(b, t, 2, NSA_KV_HEADS, NSA_HD)
    kv_w = kv_w.reshape(b, t, 2, NSA_KV_HEADS, NSA_HD)
    g_n = jax.nn.sigmoid(g_n).reshape(b, t, NSA_HEADS, 3)
    q_g = q_g.reshape(b, t, GLA_HEADS, GLA_DK) * (GLA_DK ** -0.5)
    k_g = k_g.reshape(b, t, GLA_HEADS, GLA_DK)
    v_g = v_g.reshape(b, t, GLA_HEADS, GLA_DV)
    a_pre = (jnp.einsum('btr,re->bte', a_g, gla_wa2) + gla_ba).astype(jnp.float32)
    log_a = (jax.nn.log_sigmoid(a_pre) / GLA_TAU).reshape(b, t, GLA_HEADS, GLA_DK)
    o_nsa, o_gla, state = mix_fn(q_n, g_n, kv_c, kv_s, kv_w, q_g, k_g, v_g, log_a)
    o_gla = rms_norm(o_gla, gla_norm).reshape(b, t, GLA_WIDTH) * jax.nn.silu(o_g)
    y = jnp.einsum('bte,ed->btd', jnp.concatenate([o_nsa, o_gla], axis=-1), w_out)
    x = x + mod[:, :, 5] * y
    h = rms_norm(x, norm_g[2]) * (1.0 + mod[:, :, 7]) + mod[:, :, 6]
    x = x + 0.5 * mod[:, :, 8] * swiglu(h, f2_in, f2_out)
    return x, state


def setup_inputs(seed: int = 0) -> dict:
    key = jax.random.key(seed)
    ks = jax.random.split(key, 32)
    f32 = jnp.float32
    n_pages = PAST_LEN // PAGE_SIZE
    n_used = DEC_BATCH * n_pages
    n_phys = n_used + max(n_used // 4, 1)
    win_len = min(WINDOW, PAST_LEN)

    def nrm(k, shape, scale):
        return scale * jax.random.normal(k, shape, f32)

    page_table = jax.random.permutation(ks[8], n_phys)[:n_used].reshape(DEC_BATCH, n_pages).astype(jnp.int32)
    kv_shape = (DEPTH, n_phys, PAGE_SIZE, 2, NSA_KV_HEADS, NSA_HD)
    return {
        'x_prompt': nrm(ks[0], (BATCH, SEQ, D_MODEL), 1.0),
        'x_sample': nrm(ks[1], (DEC_BATCH, DEC_SEQ, D_MODEL), 1.0),
        'c_prompt': nrm(ks[2], (BATCH, D_MODEL), 1.0),
        'c_sample': nrm(ks[3], (DEC_BATCH, D_MODEL), 1.0),
        'cache_kv_cmp': nrm(ks[4], kv_shape, 1.0),
        'cache_kv_slc': nrm(ks[5], kv_shape, 1.0),
        'cache_kv_win': nrm(ks[6], (DEPTH, DEC_BATCH, win_len, 2, NSA_KV_HEADS, NSA_HD), 1.0),
        'state_gla': nrm(ks[7], (DEPTH, DEC_BATCH, GLA_HEADS, GLA_DK, GLA_DV), 0.3),
        'page_table': page_table,
        'w_ada': nrm(ks[9], (DEPTH, D_MODEL, N_MOD * D_MODEL), 0.5 * D_MODEL ** -0.5),
        'b_ada': nrm(ks[10], (DEPTH, N_MOD * D_MODEL), 0.02),
        'norm_g': 1.0 + nrm(ks[11], (DEPTH, 3, D_MODEL), 0.05),
        'ffn1_w_in': nrm(ks[12], (DEPTH, D_MODEL, 2 * FFN_DIM), D_MODEL ** -0.5),
        'ffn1_w_out': nrm(ks[13], (DEPTH, FFN_DIM, D_MODEL), FFN_DIM ** -0.5),
        'w_in': nrm(ks[14], (DEPTH, D_MODEL, IN_COLS), D_MODEL ** -0.5),
        'cmp_pe': nrm(ks[15], (DEPTH, 2, CMP_BLOCK, NSA_HD), 0.1),
        'cmp_w1': nrm(ks[16], (DEPTH, 2, CMP_BLOCK * NSA_HD, CMP_HIDDEN), (CMP_BLOCK * NSA_HD) ** -0.5),
        'cmp_b1': nrm(ks[17], (DEPTH, 2, CMP_HIDDEN), 0.02),
        'cmp_w2': nrm(ks[18], (DEPTH, 2, CMP_HIDDEN, NSA_HD), CMP_HIDDEN ** -0.5),
        'gla_wa2': nrm(ks[19], (DEPTH, GLA_RANK, GLA_HEADS * GLA_DK), GLA_RANK ** -0.5),
        'gla_ba': nrm(ks[20], (DEPTH, GLA_HEADS * GLA_DK), 0.1),
        'gla_norm': 1.0 + nrm(ks[21], (DEPTH, GLA_DV), 0.05),
        'w_out': nrm(ks[22], (DEPTH, D_MIX, D_MODEL), D_MIX ** -0.5),
        'ffn2_w_in': nrm(ks[23], (DEPTH, D_MODEL, 2 * FFN_DIM), D_MODEL ** -0.5),
        'ffn2_w_out': nrm(ks[24], (DEPTH, FFN_DIM, D_MODEL), FFN_DIM ** -0.5),
        'final_norm': 1.0 + nrm(ks[25], (D_MODEL,), 0.05),
    }


def reference(x_prompt, x_sample, c_prompt, c_sample, cache_kv_cmp, cache_kv_slc, cache_kv_win, state_gla,
              page_table, w_ada, b_ada, norm_g, ffn1_w_in, ffn1_w_out, w_in, cmp_pe, cmp_w1, cmp_b1, cmp_w2,
              gla_wa2, gla_ba, gla_norm, w_out, ffn2_w_in, ffn2_w_out, final_norm):
    slopes = alibi_slopes(NSA_HEADS)
    xp, xs = x_prompt, x_sample
    p_c, p_s, p_w, p_g = [], [], [], []
    s_c, s_s, s_w, s_g = [], [], [], []
    for l in range(DEPTH):
        cmp = (cmp_pe[l], cmp_w1[l], cmp_b1[l], cmp_w2[l])
        common = (w_ada[l], b_ada[l], norm_g[l], ffn1_w_in[l], ffn1_w_out[l], w_in[l], gla_wa2[l], gla_ba[l],
                  gla_norm[l], w_out[l], ffn2_w_in[l], ffn2_w_out[l])
        fp = functools.partial(mix_prompt, cmp=cmp, slopes=slopes)
        fs = functools.partial(mix_sample, cmp=cmp, slopes=slopes, cache_c=cache_kv_cmp[l],
                               cache_s=cache_kv_slc[l], cache_w=cache_kv_win[l], state=state_gla[l],
                               page_table=page_table)
        xp, stp = trunk_layer(xp, c_prompt, fp, *common)
        xs, sts = trunk_layer(xs, c_sample, fs, *common)
        p_c.append(stp[0]); p_s.append(stp[1]); p_w.append(stp[2]); p_g.append(stp[3])
        s_c.append(sts[0]); s_s.append(sts[1]); s_w.append(sts[2]); s_g.append(sts[3])
    y_prompt = rms_norm(xp, final_norm)
    y_sample = rms_norm(xs, final_norm)
    return (y_prompt, y_sample, jnp.stack(p_c), jnp.stack(p_s), jnp.stack(p_w), jnp.stack(p_g),
            jnp.stack(s_c), jnp.stack(s_s), jnp.stack(s_w), jnp.stack(s_g))
```

```cpp
#include <hip/hip_runtime.h>
#include <cstdio>
#include <cstdint>
#ifndef MK_SINGLE
#define MK_SINGLE 1
#endif
namespace pg8 {
#define PG8_LAS __attribute__((address_space(3)))
typedef unsigned short bf16_t;
typedef short bf16x8 __attribute__((ext_vector_type(8)));
typedef float f32x4 __attribute__((ext_vector_type(4)));
typedef unsigned u32x4 __attribute__((ext_vector_type(4)));
constexpr int BM = 256, BK = 64, HALF = 128, HTB = HALF * BK * 2  , STAGE_BYTES = 8 * HTB, NXCD = 8, WGM = 8;

__host__ __device__ __forceinline__ int lds_byte(int r, int c) { const int st = (r >> 4) * 2 + (c >> 5), rr = r & 15, cc = c & 31, ob = rr * 64 + cc * 2; return st * 1024 + (ob ^ (((ob >> 9) & 1) << 5)); }
__host__ __device__ __forceinline__ void stage_rc(int b, int& R, int& C) { const int st = b / 1024, sb = b % 1024, swz = sb ^ (((sb >> 9) & 1) << 5); R = (st >> 1) * 16 + swz / 64; C = (st & 1) * 32 + (swz % 64) / 2; }
__host__ __device__ __forceinline__ int perm32(int rho) { const int n = rho >> 4, i = rho & 15; return 8 * (i >> 2) + 4 * n + (i & 3); }

struct Unit { int pm, pn; };
struct Gemm { const bf16_t* A; const bf16_t* Bt; int M, N, K; };

struct StaticOrder {
    int nM, nN, nwg, G, c;
    __host__ __device__ void init(int M, int N, int G_, int c_) { nM = M / BM; nN = N / BM; nwg = nM * nN; G = G_; c = c_; }
    __host__ __device__ bool next(int i, Unit& u) const {
        const long L = (long)i * G + c; if (L >= nwg) return false;
        int wgid = (int)L; { const int q = nwg / NXCD, r = nwg % NXCD, xcd = wgid % NXCD, off = wgid / NXCD; wgid = (xcd < r ? xcd * (q + 1) : r * (q + 1) + (xcd - r) * q) + off; }
        const int nig = WGM * nN, gid = wgid / nig, fm = gid * WGM, gsz = (nM - fm) < WGM ? (nM - fm) : WGM;
        u.pm = fm + ((wgid % nig) % gsz); u.pn = (wgid % nig) / gsz; return true;
    }
    __device__ __forceinline__ void a_ready(const Unit&) const {}
    __device__ __forceinline__ void done(const Unit&) const {}
};

__device__ __forceinline__ unsigned cvt_pk_bf16(float lo, float hi) { unsigned r; asm volatile("v_cvt_pk_bf16_f32 %0, %1, %2" : "=v"(r) : "v"(lo), "v"(hi)); return r; }
typedef float f32x2 __attribute__((ext_vector_type(2)));
template <class Epi, class Sched, bool ALIGN_EPI = false, bool SP2 = false>
__device__ __forceinline__ void gemm_phase(PG8_LAS unsigned char* lds, const Gemm g, const Sched& S, const Epi& E) {
    int tid_ = threadIdx.x; asm volatile("" : "+v"(tid_));
    const int tid = tid_, wid = __builtin_amdgcn_readfirstlane(tid >> 6), lane = tid & 63, wr = wid >> 2, wc = wid & 3, fr = lane & 15, fq = lane >> 4;
    const int K = g.K, nt = K / BK;
    unsigned voffA[2], voffB[2];
#pragma unroll
    for (int i = 0; i < 2; ++i) { int R, C; stage_rc(tid * 16 + i * 8192, R, C); const int Rb = Epi::PERM ? ((R & ~31) + perm32(R & 31)) : R;
        voffA[i] = (unsigned)(R * K + C) * 2u; voffB[i] = (unsigned)(Rb * K + C) * 2u; }
    const size_t kstep = (size_t)(BK * 2);
    const size_t hstep = (size_t)HALF * K * 2;
    const size_t tstep = 2 * hstep;
    const unsigned ldsw = (unsigned)wid * 1024u;
    const int aoff = lds_byte(wr * 64 + fr, fq * 8), boff = lds_byte(wc * 32 + fr, fq * 8);
#define PG8_SA(b, h) (((b) * 2 + (h)) * HTB)
#define PG8_SB(b, h) ((4 + (b) * 2 + (h)) * HTB)
#define PG8_STAGE(bufoff, gbase, voff) do { _Pragma("unroll") for (int _i = 0; _i < 2; ++_i) \
        __builtin_amdgcn_global_load_lds((const unsigned*)((const char*)(gbase) + (voff)[_i]), (PG8_LAS unsigned*)(lds + (bufoff) + ldsw + _i * 8192), 16, 0, 0); } while (0)
#define PG8_LDA(dst, b, h) do { _Pragma("unroll") for (int m = 0; m < 4; ++m) _Pragma("unroll") for (int k = 0; k < 2; ++k) dst[m][k] = *(const PG8_LAS bf16x8*)(lds + PG8_SA(b, h) + aoff + m * 2048 + k * 1024); } while (0)
#define PG8_LDB(dst, b, h) do { _Pragma("unroll") for (int n = 0; n < 2; ++n) _Pragma("unroll") for (int k = 0; k < 2; ++k) dst[n][k] = *(const PG8_LAS bf16x8*)(lds + PG8_SB(b, h) + boff + n * 2048 + k * 1024); } while (0)
#define PG8_MMA(ai, bj, At, Bt) do { __builtin_amdgcn_s_setprio(1); _Pragma("unroll") for (int m = 0; m < 4; ++m) _Pragma("unroll") for (int n = 0; n < 2; ++n) _Pragma("unroll") for (int k = 0; k < 2; ++k) \
        acc[ai][bj][m][n] = __builtin_amdgcn_mfma_f32_16x16x32_bf16(Bt[n][k], At[m][k], acc[ai][bj][m][n], 0, 0, 0); __builtin_amdgcn_s_setprio(0); } while (0)
#define PG8_WAIT_V(n) asm volatile("s_waitcnt vmcnt(" #n ")" ::: "memory")
#define PG8_WAIT_L(n) asm volatile("s_waitcnt lgkmcnt(" #n ")" ::: "memory")
#define PG8_BAR __builtin_amdgcn_s_barrier()
#define PG8_SCHED __builtin_amdgcn_sched_barrier(0)
    Unit cur, nxt; int ui = 0;
    if (!S.next(0, cur)) return;
    f32x4 acc[2][2][4][2];
#pragma unroll
    for (int a = 0; a < 2; ++a)
#pragma unroll
        for (int b = 0; b < 2; ++b)
#pragma unroll
            for (int m = 0; m < 4; ++m)
#pragma unroll
                for (int n = 0; n < 2; ++n) acc[a][b][m][n] = (f32x4){0.f, 0.f, 0.f, 0.f};
    bf16x8 At[4][2], B0[2][2], B1[2][2];
    const char* cA = (const char*)g.A + (size_t)cur.pm * tstep; const char* cB = (const char*)g.Bt + (size_t)cur.pn * tstep;
    S.a_ready(cur);
    if constexpr (SP2) {
        PG8_STAGE(PG8_SB(0, 0), cB, voffB); PG8_STAGE(PG8_SB(0, 1), cB + hstep, voffB); PG8_STAGE(PG8_SA(0, 0), cA, voffA); PG8_STAGE(PG8_SA(0, 1), cA + hstep, voffA);
        if (wr == 1) PG8_BAR;
        PG8_WAIT_V(2); PG8_BAR;
        PG8_STAGE(PG8_SB(1, 0), cB + kstep, voffB); PG8_STAGE(PG8_SA(1, 0), cA + kstep, voffA); PG8_STAGE(PG8_SB(1, 1), cB + hstep + kstep, voffB);
        PG8_WAIT_V(6); PG8_BAR;
    } else {
        PG8_STAGE(PG8_SB(0, 0), cB, voffB); PG8_STAGE(PG8_SA(0, 0), cA, voffA); PG8_STAGE(PG8_SB(0, 1), cB + hstep, voffB); PG8_STAGE(PG8_SA(0, 1), cA + hstep, voffA);
        if (wr == 1) PG8_BAR;
        PG8_WAIT_V(4); PG8_BAR;
        PG8_STAGE(PG8_SB(1, 0), cB + kstep, voffB); PG8_STAGE(PG8_SA(1, 0), cA + kstep, voffA); PG8_STAGE(PG8_SB(1, 1), cB + hstep + kstep, voffB);
        PG8_WAIT_V(6); PG8_BAR;
    }
    for (;;) {
        const bool has_next = S.next(ui + 1, nxt);
        const char* nA = has_next ? (const char*)g.A + (size_t)nxt.pm * tstep : cA; const char* nB = has_next ? (const char*)g.Bt + (size_t)nxt.pn * tstep : cB;
        for (int t = 0; t < nt; t += 2) {
            const bool last = (t == nt - 2);
            const char* a1 = cA + (size_t)(t + 1) * kstep;
            const char* a2 = last ? nA : cA + (size_t)(t + 2) * kstep; const char* b2 = last ? nB : cB + (size_t)(t + 2) * kstep;
            const char* a3 = a2 + kstep; const char* b3 = b2 + kstep;
            if (last && has_next) S.a_ready(nxt);
            if constexpr (SP2) {
            PG8_LDB(B0, 0, 0); PG8_LDB(B1, 0, 1); PG8_SCHED; PG8_LDA(At, 0, 0); PG8_STAGE(PG8_SA(1, 1), a1 + hstep, voffA);
            PG8_WAIT_V(8); PG8_WAIT_L(0); PG8_BAR; PG8_MMA(0, 0, At, B0); PG8_MMA(0, 1, At, B1); PG8_BAR; PG8_SCHED;
            PG8_LDA(At, 0, 1); PG8_STAGE(PG8_SB(0, 0), b2, voffB); PG8_STAGE(PG8_SB(0, 1), b2 + hstep, voffB); PG8_STAGE(PG8_SA(0, 0), a2, voffA);
            PG8_WAIT_V(8); PG8_WAIT_L(0); PG8_BAR; PG8_MMA(1, 0, At, B0); PG8_MMA(1, 1, At, B1); PG8_BAR; PG8_SCHED;
            PG8_LDB(B0, 1, 0); PG8_LDB(B1, 1, 1); PG8_SCHED; PG8_LDA(At, 1, 0); PG8_STAGE(PG8_SA(0, 1), a2 + hstep, voffA);
            PG8_WAIT_V(8); PG8_WAIT_L(0); PG8_BAR; PG8_MMA(0, 0, At, B0); PG8_MMA(0, 1, At, B1); PG8_BAR; PG8_SCHED;
            PG8_LDA(At, 1, 1); PG8_STAGE(PG8_SB(1, 0), b3, voffB); PG8_STAGE(PG8_SB(1, 1), b3 + hstep, voffB); PG8_STAGE(PG8_SA(1, 0), a3, voffA);
            PG8_WAIT_V(8); PG8_WAIT_L(0); PG8_BAR; PG8_MMA(1, 0, At, B0); PG8_MMA(1, 1, At, B1); PG8_BAR; PG8_SCHED;
            } else {
            PG8_LDB(B0, 0, 0); PG8_SCHED; PG8_LDA(At, 0, 0); PG8_STAGE(PG8_SA(1, 1), a1 + hstep, voffA);
            PG8_WAIT_L(8); PG8_BAR; PG8_WAIT_L(0); PG8_MMA(0, 0, At, B0); PG8_BAR; PG8_SCHED;
            PG8_LDB(B1, 0, 1); PG8_STAGE(PG8_SB(0, 0), b2, voffB);
            PG8_BAR; PG8_WAIT_L(0); PG8_MMA(0, 1, At, B1); PG8_BAR;
            PG8_LDA(At, 0, 1); PG8_STAGE(PG8_SA(0, 0), a2, voffA);
            PG8_BAR; PG8_WAIT_L(0); PG8_MMA(1, 0, At, B0); PG8_BAR; PG8_SCHED;
            PG8_STAGE(PG8_SB(0, 1), b2 + hstep, voffB);
            PG8_WAIT_V(6); PG8_BAR; PG8_MMA(1, 1, At, B1); PG8_BAR;
            PG8_LDB(B0, 1, 0); PG8_SCHED; PG8_LDA(At, 1, 0); PG8_STAGE(PG8_SA(0, 1), a2 + hstep, voffA);
            PG8_WAIT_L(8); PG8_BAR; PG8_WAIT_L(0); PG8_MMA(0, 0, At, B0); PG8_BAR; PG8_SCHED;
            PG8_LDB(B1, 1, 1); PG8_STAGE(PG8_SB(1, 0), b3, voffB);
            PG8_BAR; PG8_WAIT_L(0); PG8_MMA(0, 1, At, B1); PG8_BAR;
            PG8_LDA(At, 1, 1); PG8_STAGE(PG8_SA(1, 0), a3, voffA);
            PG8_BAR; PG8_WAIT_L(0); PG8_MMA(1, 0, At, B0); PG8_BAR; PG8_SCHED;
            PG8_STAGE(PG8_SB(1, 1), b3 + hstep, voffB);
            PG8_WAIT_V(6); PG8_BAR; PG8_MMA(1, 1, At, B1); PG8_BAR;
            }
        }
        if constexpr (ALIGN_EPI) { if (wr == 0) PG8_BAR; }
        if constexpr (!Epi::AFTER_DRAIN) { E(acc, cur, wr, wc, fr, fq); S.done(cur); }
        if (!has_next) break;
#pragma unroll
        for (int a = 0; a < 2; ++a)
#pragma unroll
            for (int b = 0; b < 2; ++b)
#pragma unroll
                for (int m = 0; m < 4; ++m)
#pragma unroll
                    for (int n = 0; n < 2; ++n) acc[a][b][m][n] = (f32x4){0.f, 0.f, 0.f, 0.f};
        cur = nxt; cA = nA; cB = nB; ++ui;
        if constexpr (ALIGN_EPI) { if (wr == 1) PG8_BAR; }
    }
    PG8_WAIT_V(0);
    if constexpr (!ALIGN_EPI) { if (wr == 0) PG8_BAR; }
    PG8_BAR;
    if constexpr (Epi::AFTER_DRAIN) { E.fused(acc, cur, wr, wc, fr, fq, lds, wid, lane); S.done(cur); }
#undef PG8_SA
#undef PG8_SB
#undef PG8_STAGE
#undef PG8_LDA
#undef PG8_LDB
#undef PG8_MMA
#undef PG8_WAIT_V
#undef PG8_WAIT_L
#undef PG8_BAR
#undef PG8_SCHED
}
}
#define GAS __attribute__((address_space(1)))
#define LAS __attribute__((address_space(3)))
typedef unsigned short bf16;
typedef unsigned v4u __attribute__((ext_vector_type(4)));
typedef unsigned v2u __attribute__((ext_vector_type(2)));
typedef float f32x4 __attribute__((ext_vector_type(4)));
typedef GAS unsigned gu32;
#define RLX_AGENT __ATOMIC_RELAXED, __HIP_MEMORY_SCOPE_AGENT
#define WSYNC() asm volatile("s_waitcnt lgkmcnt(0)" ::: "memory")
__device__ __forceinline__ unsigned f2bf(float f) { unsigned u = __builtin_bit_cast(unsigned, f); return (u + 0x7fffu + ((u >> 16) & 1u)) >> 16; }
__device__ __forceinline__ unsigned pk2(float lo, float hi) { return f2bf(lo) | (f2bf(hi) << 16); }
__device__ __forceinline__ float wave_sum(float v) {
#pragma unroll
    for (int o = 1; o < 64; o <<= 1) v += __shfl_xor(v, o);
    return v;
}
__device__ __forceinline__ float wave_max(float v) {
#pragma unroll
    for (int o = 1; o < 64; o <<= 1) v = fmaxf(v, __shfl_xor(v, o));
    return v;
}
__device__ __forceinline__ float sigmoidf_(float x) { return 1.0f / (1.0f + __expf(-x)); }
__device__ __forceinline__ float siluf_(float x) { return x / (1.0f + __expf(-x)); }

constexpr int D = 1024, TP = 8192, MP = 16384, MS = 128, MTOT = 16512, MPAD = 16640;
constexpr int FF = 2816, NIN = 2856, NINP = 3072, MODW = 9216, NMODROWS = 130;
constexpr int NPHYS = 2560;
constexpr int C_KVC = 512, C_KVS = 768, C_KVW = 1024, C_GN = 1280, C_QG = 1304, C_KG = 1560, C_VG = 1816, C_AG = 2328, C_OG = 2344;
constexpr size_t O_YP = 0, O_YS = 16777216, O_PKVC = 16908288, O_PKVS = 25296896, O_PKVW = 33685504, O_PGLA = 34209792,
                 O_SKVC = 34340864, O_SKVS = 34406400, O_SKVW = 34471936, O_SGLA = 34537472, O_END = 42926080;
constexpr size_t MiB = 1u << 20;
constexpr size_t WS_CTL = 0, CTL_ZERO_BYTES = 1 * MiB;
constexpr size_t WS_W = 2 * MiB, WL_STRIDE = 42 * MiB;
constexpr size_t WO_W1 = 0, WO_W2 = 11 * MiB, WO_WIN = 11 * MiB + 5632 * 1024, WO_WO = WO_WIN + 6 * MiB, WO_W3 = WO_WO + 2 * MiB, WO_W4 = WO_W3 + 11 * MiB;
static_assert(WO_W4 + 5632 * 1024 <= WL_STRIDE, "weights");
constexpr size_t WS_MOD = 88 * MiB;
constexpr size_t WS_HBP = 98 * MiB;
constexpr size_t WS_CKP = 100 * MiB;
constexpr size_t WS_CKS = 102 * MiB;
constexpr size_t WS_X = 120 * MiB;
constexpr size_t WS_HN = 186 * MiB;
constexpr size_t WS_O = 220 * MiB;
constexpr size_t WS_HF = 256 * MiB;
constexpr size_t WS_P = 352 * MiB;
constexpr size_t WS_GKV = 548 * MiB;
constexpr size_t WS_GS0 = 580 * MiB;
constexpr size_t WS_GDEC = 612 * MiB;
constexpr size_t WS_END = 616 * MiB;
constexpr int CW_BAR = 4096;
constexpr int RING_BYTES = 131072, MISC_OFF = RING_BYTES + 320, LDS_BYTES = 147456;
constexpr int NWAVES = 8, NTHR = 512;
constexpr int NPHASES = 26;

#define XB_TMO      128
#define XB_XCNT(j)  (256  + 64 * (j))
#define XB_XSUB(j)  (1280 + 64 * (j))
#define XB_XGEN(j)  (2304 + 64 * (j))
#define XB_TOP      3328
#define XB_TOPGEN   3392
#define XCD_BAR_WORDS 3456
#define XB_SPIN_CAP (1u << 18)

__device__ __forceinline__ unsigned xb_ld(unsigned* p)              { return __hip_atomic_load(p, __ATOMIC_RELAXED, __HIP_MEMORY_SCOPE_AGENT); }
__device__ __forceinline__ unsigned xb_add(unsigned* p, unsigned v) { return __hip_atomic_fetch_add(p, v, __ATOMIC_RELAXED, __HIP_MEMORY_SCOPE_AGENT); }
__device__ __forceinline__ unsigned xb_xcc_id() { return (unsigned)__builtin_amdgcn_s_getreg((3 << 11) | 20) & 0xFu; }
#define XB_SPIN(cond, bar) do { unsigned _sp = 0; while (cond) { __builtin_amdgcn_s_sleep(1); \
    if ((++_sp & 255u) == 0u) { if (xb_ld(&(bar)[XB_TMO])) break; if (_sp > XB_SPIN_CAP) { atomicAdd(&(bar)[XB_TMO], 1u); break; } } } } while (0)

struct XcdBarrier {
    unsigned* bar; unsigned x;
    volatile LAS unsigned* st;
};

__device__ __forceinline__ XcdBarrier xcd_barrier_post(unsigned* bar, volatile LAS unsigned* st) {
    XcdBarrier b; b.bar = bar; b.x = xb_xcc_id(); b.st = st;
    if (threadIdx.x == 0) (void)xb_add(&bar[XB_XCNT(b.x)], 1u);
    return b;
}
__device__ __forceinline__ void xcd_barrier_complete(unsigned* bar, unsigned x, unsigned& nloc, unsigned& nx) {
    const unsigned G = gridDim.x * gridDim.y * gridDim.z;
    unsigned sum, cnt, mine, sp = 0u;
    for (;;) {
        sum = 0u; cnt = 0u; mine = 0u;
#pragma unroll
        for (unsigned j = 0; j < 16; ++j) { const unsigned c = xb_ld(&bar[XB_XCNT(j)]); sum += c; cnt += (c > 0u) ? 1u : 0u; mine = (j == x) ? c : mine; }
        if (sum == G) break;
        __builtin_amdgcn_s_sleep(1);
        if ((++sp & 255u) == 0u) { if (xb_ld(&bar[XB_TMO])) break; if (sp > XB_SPIN_CAP) { atomicAdd(&bar[XB_TMO], 1u); break; } }
    }
    nloc = mine > 0u ? mine : 1u; nx = cnt > 0u ? cnt : 1u;
}

__device__ __forceinline__ void xcd_barrier(const XcdBarrier& b) {
    asm volatile("s_waitcnt vmcnt(0)" ::: "memory");
    __syncthreads();
    if (threadIdx.x == 0) {
        unsigned* bar = b.bar;
        __builtin_amdgcn_s_waitcnt(0);
        unsigned nloc = b.st[0], nx = b.st[1];
        if (nloc == 0u) { xcd_barrier_complete(bar, b.x, nloc, nx); b.st[0] = nloc; b.st[1] = nx; }
        const unsigned old = xb_add(&bar[XB_XSUB(b.x)], 1u);
        const unsigned gen = old / nloc;
        if (old + 1u == (gen + 1u) * nloc) {
            __builtin_amdgcn_fence(__ATOMIC_RELEASE, "agent");
            asm volatile("s_waitcnt vmcnt(0)" ::: "memory");
            const unsigned og = xb_add(&bar[XB_TOP], 1u);
            const unsigned tg = og / nx;
            if (og + 1u == (tg + 1u) * nx) xb_add(&bar[XB_TOPGEN], 1u);
            else XB_SPIN(xb_ld(&bar[XB_TOPGEN]) == tg, bar);
            __builtin_amdgcn_fence(__ATOMIC_ACQUIRE, "agent");
            xb_add(&bar[XB_XGEN(b.x)], 1u);
            asm volatile("s_waitcnt vmcnt(0)" ::: "memory");
        } else {
            XB_SPIN(xb_ld(&bar[XB_XGEN(b.x)]) == gen, bar);
            __builtin_amdgcn_fence(__ATOMIC_ACQUIRE, "agent");
            asm volatile("s_waitcnt vmcnt(0)" ::: "memory");
        }
    }
    __syncthreads();
}
typedef __attribute__((address_space(4))) const void* const volatile* KArgPtr;
struct Args { const void* in[26]; float* out; unsigned char* ws; int ph_lo, ph_hi; };
struct Frame {
    LAS unsigned char* lds;
    volatile LAS unsigned* MISC;
    gu32* ctl;
    int tid, lane, wave, G, gw, NGW;
    unsigned char* ws;
    float* out;
    int bx;
    KArgPtr ka;
};
__device__ __forceinline__ int modrow(int m) { return m < MP ? (m >> 13) : 2 + (m - MP); }

__device__ __forceinline__ void transpose_item(const float* W, int K, int N, bf16* WT, int drow0, LAS float* scr, int k0, int n0, int lane) {
#pragma unroll 8
    for (int i = 0; i < 32; ++i) { const int kk = 2 * i + (lane >> 5); const int n = n0 + (lane & 31); scr[kk * 33 + (lane & 31)] = (n < N) ? W[(size_t)(k0 + kk) * N + n] : 0.f; }
    WSYNC(); asm volatile("" ::: "memory");
    const int c = lane & 7;
#pragma unroll
    for (int j = 0; j < 4; ++j) { const int n = (lane >> 3) + 8 * j; const LAS float* s = scr + (8 * c) * 33 + n;
        v4u o; o.x = pk2(s[0 * 33], s[1 * 33]); o.y = pk2(s[2 * 33], s[3 * 33]); o.z = pk2(s[4 * 33], s[5 * 33]); o.w = pk2(s[6 * 33], s[7 * 33]);
        *(GAS v4u*)(WT + (size_t)(drow0 + n) * K + k0 + 8 * c) = o; }
    WSYNC(); asm volatile("" ::: "memory");
}
__device__ __forceinline__ int swiglu_row(int n0) { return (n0 < FF) ? (n0 / 128) * 256 + (n0 % 128) : ((n0 - FF) / 128) * 256 + 128 + ((n0 - FF) % 128); }

__device__ __forceinline__ void p0_prologue(Frame& F) {
    {
        LAS float* scr = (LAS float*)(F.lds + F.wave * 16384);
        constexpr int I1 = 16 * 176, I2 = 44 * 32, I3 = 16 * 96, I4 = 16 * 32, IL = 2 * I1 + 2 * I2 + I3 + I4;
        for (int it = F.gw; it < 2 * IL; it += F.NGW) {
            const int l = it / IL; int r = it % IL;
            unsigned char* wl = F.ws + WS_W + (size_t)l * WL_STRIDE;
            if (r < I1) { const int kb = r / 176, nb = r % 176; transpose_item(((const float*)F.ka[12]) + (size_t)l * D * 2 * FF, D, 2 * FF, (bf16*)(wl + WO_W1), swiglu_row(nb * 32), scr, kb * 64, nb * 32, F.lane); continue; } r -= I1;
            if (r < I2) { const int kb = r / 32, nb = r % 32; transpose_item(((const float*)F.ka[13]) + (size_t)l * FF * D, FF, D, (bf16*)(wl + WO_W2), nb * 32, scr, kb * 64, nb * 32, F.lane); continue; } r -= I2;
            if (r < I3) { const int kb = r / 96, nb = r % 96; transpose_item(((const float*)F.ka[14]) + (size_t)l * D * NIN, D, NIN, (bf16*)(wl + WO_WIN), nb * 32, scr, kb * 64, nb * 32, F.lane); continue; } r -= I3;
            if (r < I4) { const int kb = r / 32, nb = r % 32; transpose_item(((const float*)F.ka[22]) + (size_t)l * D * D, D, D, (bf16*)(wl + WO_WO), nb * 32, scr, kb * 64, nb * 32, F.lane); continue; } r -= I4;
            if (r < I1) { const int kb = r / 176, nb = r % 176; transpose_item(((const float*)F.ka[23]) + (size_t)l * D * 2 * FF, D, 2 * FF, (bf16*)(wl + WO_W3), swiglu_row(nb * 32), scr, kb * 64, nb * 32, F.lane); continue; } r -= I1;
            { const int kb = r / 32, nb = r % 32; transpose_item(((const float*)F.ka[24]) + (size_t)l * FF * D, FF, D, (bf16*)(wl + WO_W4), nb * 32, scr, kb * 64, nb * 32, F.lane); }
        }
    }
    for (int m = F.gw; m < MPAD; m += F.NGW) {
        const float* src = (m < MP) ? ((const float*)F.ka[0]) + (size_t)m * D : (m < MTOT ? ((const float*)F.ka[1]) + (size_t)(m - MP) * D : nullptr);
        f32x4* xo = (f32x4*)(((float*)(F.ws + WS_X)) + (size_t)m * D) + F.lane;
#pragma unroll
        for (int j = 0; j < 4; ++j) xo[64 * j] = src ? ((const f32x4*)src)[F.lane + 64 * j] : (f32x4){0.f, 0.f, 0.f, 0.f};
        if (m >= MTOT) {
            v4u z = {0u, 0u, 0u, 0u};
            v4u* h = (v4u*)(((bf16*)(F.ws + WS_HN)) + (size_t)m * D) + F.lane; h[0] = z; h[64] = z;
            v4u* o = (v4u*)(((bf16*)(F.ws + WS_O)) + (size_t)m * D) + F.lane; o[0] = z; o[64] = z;
        }
    }
    if (F.bx < 8) {
        const int ks = F.bx, lk = F.tid >> 7, j = F.tid & 127;
        const float* pe = ((const float*)F.ka[15]) + (size_t)lk * 2048 + ks * 256;
        const float* w1 = ((const float*)F.ka[16]) + (size_t)lk * 2048 * 128 + (size_t)ks * 256 * 128 + j;
        float a = 0.f;
        for (int k = 0; k < 256; ++k) a += pe[k] * w1[(size_t)k * 128];
        ((float*)(F.ws + WS_HBP))[(ks * 4 + lk) * 128 + j] = a;
    }
    {
        __syncthreads();
        LAS float* S = (LAS float*)F.lds;
        const int col = F.tid & 63, rg = F.tid >> 6, r0 = rg * 17;
        for (int slab = F.bx; slab < 288; slab += F.G) {
            const int l = slab / 144, e0 = (slab % 144) * 64;
            const float* W = ((const float*)F.ka[9]) + (size_t)l * D * MODW + e0 + col;
            float acc[17];
#pragma unroll
            for (int j = 0; j < 17; ++j) acc[j] = 0.f;
            for (int d0 = 0; d0 < D; d0 += 128) {
                __syncthreads();
                for (int idx = F.tid; idx < 136 * 128; idx += NTHR) {
                    const int r = idx >> 7, dd = idx & 127;
                    float v = 0.f;
                    if (r < 2) v = ((const float*)F.ka[2])[r * D + d0 + dd]; else if (r < NMODROWS) v = ((const float*)F.ka[3])[(r - 2) * D + d0 + dd];
                    S[idx] = siluf_(v);
                }
                __syncthreads();
                for (int dd = 0; dd < 128; dd += 4) {
                    const float w0 = W[(size_t)(d0 + dd) * MODW], w1 = W[(size_t)(d0 + dd + 1) * MODW], w2 = W[(size_t)(d0 + dd + 2) * MODW], w3 = W[(size_t)(d0 + dd + 3) * MODW];
#pragma unroll
                    for (int j = 0; j < 17; ++j) { const f32x4 s = *(const LAS f32x4*)&S[(r0 + j) * 128 + dd]; acc[j] += s.x * w0 + s.y * w1 + s.z * w2 + s.w * w3; }
                }
            }
            const float bb = ((const float*)F.ka[10])[(size_t)l * MODW + e0 + col];
#pragma unroll
            for (int j = 0; j < 17; ++j) { const int r = r0 + j; if (r < NMODROWS) ((float*)(F.ws + WS_MOD))[((size_t)l * NMODROWS + r) * MODW + e0 + col] = acc[j] + bb; }
        }
        __syncthreads();
    }
}

__device__ __forceinline__ void norm_phase(Frame& F, int l, int sub) {
    const float* gvec = ((const float*)F.ka[11]) + ((size_t)l * 3 + sub) * D;
    for (int m = F.gw; m < MTOT; m += F.NGW) {
        const f32x4* xr = (const f32x4*)(((float*)(F.ws + WS_X)) + (size_t)m * D) + F.lane;
        f32x4 v[4]; float s = 0.f;
#pragma unroll
        for (int j = 0; j < 4; ++j) { v[j] = xr[64 * j]; s += (v[j].x * v[j].x + v[j].y * v[j].y) + (v[j].z * v[j].z + v[j].w * v[j].w); }
        const float rstd = 1.0f / sqrtf(wave_sum(s) * (1.0f / D) + 1e-6f);
        const float* mrow = ((float*)(F.ws + WS_MOD)) + ((size_t)l * NMODROWS + modrow(m)) * MODW + (size_t)(3 * sub) * D;
        v2u* o8 = (v2u*)(((bf16*)(F.ws + WS_HN)) + (size_t)m * D) + F.lane;
#pragma unroll
        for (int j = 0; j < 4; ++j) {
            const int c = 4 * F.lane + 256 * j;
            const f32x4 g = *(const f32x4*)(gvec + c), sh = *(const f32x4*)(mrow + c), sc = *(const f32x4*)(mrow + D + c);
            const f32x4 h = (v[j] * rstd * g) * (sc + 1.0f) + sh;
            v2u w; w.x = pk2(h.x, h.y); w.y = pk2(h.z, h.w); o8[64 * j] = w;
        }
    }
}
__device__ __forceinline__ void final_norm_phase(Frame& F) {
    for (int m = F.gw; m < MTOT; m += F.NGW) {
        const f32x4* xr = (const f32x4*)(((float*)(F.ws + WS_X)) + (size_t)m * D) + F.lane;
        f32x4 v[4]; float s = 0.f;
#pragma unroll
        for (int j = 0; j < 4; ++j) { v[j] = xr[64 * j]; s += (v[j].x * v[j].x + v[j].y * v[j].y) + (v[j].z * v[j].z + v[j].w * v[j].w); }
        const float rstd = 1.0f / sqrtf(wave_sum(s) * (1.0f / D) + 1e-6f);
        float* orow = (m < MP) ? F.out + O_YP + (size_t)m * D : F.out + O_YS + (size_t)(m - MP) * D;
#pragma unroll
        for (int j = 0; j < 4; ++j) { const int c = 4 * F.lane + 256 * j; const f32x4 g = *(const f32x4*)(((const float*)F.ka[25]) + c); *(f32x4*)(orow + c) = v[j] * rstd * g; }
    }
}

struct EpiSwiGLU {
    static constexpr bool PERM = true, AFTER_DRAIN = false;
    bf16* HFp;
    __device__ __forceinline__ void operator()(const pg8::f32x4 (&acc)[2][2][4][2], const pg8::Unit& u, int wr, int wc, int fr, int fq) const {
        const int row0 = u.pm * 256 + wr * 64 + fr, col0 = u.pn * 128 + wc * 32 + 8 * fq;
#pragma unroll
        for (int ai = 0; ai < 2; ++ai)
#pragma unroll
            for (int m = 0; m < 4; ++m) {
                const pg8::f32x4 g0 = acc[ai][0][m][0], g1 = acc[ai][0][m][1], u0 = acc[ai][1][m][0], u1 = acc[ai][1][m][1];
                pg8::u32x4 w;
                w.x = pg8::cvt_pk_bf16(siluf_(g0[0]) * u0[0], siluf_(g0[1]) * u0[1]); w.y = pg8::cvt_pk_bf16(siluf_(g0[2]) * u0[2], siluf_(g0[3]) * u0[3]);
                w.z = pg8::cvt_pk_bf16(siluf_(g1[0]) * u1[0], siluf_(g1[1]) * u1[1]); w.w = pg8::cvt_pk_bf16(siluf_(g1[2]) * u1[2], siluf_(g1[3]) * u1[3]);
                *(pg8::u32x4*)(HFp + (size_t)(row0 + ai * 128 + m * 16) * FF + col0) = w;
            }
    }
};
struct EpiResid {
    static constexpr bool PERM = false, AFTER_DRAIN = false;
    float* Xp; const float* modl; int gofs; float coef;
    __device__ __forceinline__ void operator()(const pg8::f32x4 (&acc)[2][2][4][2], const pg8::Unit& u, int wr, int wc, int fr, int fq) const {
#pragma unroll
        for (int ai = 0; ai < 2; ++ai)
#pragma unroll
            for (int m = 0; m < 4; ++m) {
                const int row = u.pm * 256 + ai * 128 + wr * 64 + m * 16 + fr;
                if (row < MTOT) {
                    const float* g = modl + (size_t)modrow(row) * MODW + gofs; float* xr = Xp + (size_t)row * D;
#pragma unroll
                    for (int bj = 0; bj < 2; ++bj)
#pragma unroll
                        for (int n = 0; n < 2; ++n) {
                            const int col = u.pn * 256 + bj * 128 + wc * 32 + n * 16 + fq * 4;
                            const pg8::f32x4 gv = *(const pg8::f32x4*)(g + col); pg8::f32x4 xv = *(pg8::f32x4*)(xr + col);
                            xv += gv * acc[ai][bj][m][n] * coef; *(pg8::f32x4*)(xr + col) = xv;
                        }
                }
            }
    }
};
struct EpiF32 {
    static constexpr bool PERM = false, AFTER_DRAIN = false;
    float* Pp; int ldc;
    __device__ __forceinline__ void operator()(const pg8::f32x4 (&acc)[2][2][4][2], const pg8::Unit& u, int wr, int wc, int fr, int fq) const {
#pragma unroll
        for (int ai = 0; ai < 2; ++ai)
#pragma unroll
            for (int m = 0; m < 4; ++m) {
                float* pr = Pp + (size_t)(u.pm * 256 + ai * 128 + wr * 64 + m * 16 + fr) * ldc;
#pragma unroll
                for (int bj = 0; bj < 2; ++bj)
#pragma unroll
                    for (int n = 0; n < 2; ++n) *(pg8::f32x4*)(pr + u.pn * 256 + bj * 128 + wc * 32 + n * 16 + fq * 4) = acc[ai][bj][m][n];
            }
    }
};
__device__ __forceinline__ float gelu_tanh(float x) { const float u = 0.7978845608028654f * (x + 0.044715f * x * x * x); return 0.5f * x * (1.0f + tanhf(u)); }
__device__ __forceinline__ float log_sigmoid_(float a) { return fminf(a, 0.f) - log1pf(__expf(-fabsf(a))); }

__device__ __forceinline__ void kv_out_phase(Frame& F, int l) {
    for (int m = F.gw; m < MTOT; m += F.NGW) {
        const f32x4* pr = (const f32x4*)(((float*)(F.ws + WS_P)) + (size_t)m * NINP);
        const f32x4 a = pr[C_KVC / 4 + F.lane], b = pr[C_KVS / 4 + F.lane], c = pr[C_KVW / 4 + F.lane];
        if (m < MP) {
            ((f32x4*)(F.out + O_PKVC + ((size_t)l * MP + m) * 256))[F.lane] = a;
            ((f32x4*)(F.out + O_PKVS + ((size_t)l * MP + m) * 256))[F.lane] = b;
            const int t = m & (TP - 1), bb = m >> 13;
            if (t >= TP - 512) ((f32x4*)(F.out + O_PKVW + ((size_t)(l * 2 + bb) * 512 + (t - (TP - 512))) * 256))[F.lane] = c;
        } else {
            const int sb = m - MP;
            ((f32x4*)(F.out + O_SKVC + ((size_t)l * MS + sb) * 256))[F.lane] = a;
            ((f32x4*)(F.out + O_SKVS + ((size_t)l * MS + sb) * 256))[F.lane] = b;
            ((f32x4*)(F.out + O_SKVW + ((size_t)l * MS + sb) * 256))[F.lane] = c;
        }
    }
}

__device__ __forceinline__ void compress_phase(Frame& F, int l) {
    LAS float* XS = (LAS float*)F.lds;
    LAS float* H = (LAS float*)(F.lds + 144 * 128 * 4);
    const int j = F.tid & 127, rg = F.tid >> 7;
    for (int it = F.bx; it < 256 + 4096; it += F.G) {
        int seq, kv, ig; const bool smp = it >= 256;
        if (!smp) { seq = it >> 7; kv = (it >> 6) & 1; ig = it & 63; } else { const int r = it - 256; seq = r >> 5; kv = (r >> 4) & 1; ig = r & 15; }
        const int i0 = ig * 8, p0 = i0 * 16, nblk = smp ? 127 : 511;
        __syncthreads();
        for (int idx = F.tid; idx < 144 * 32; idx += NTHR) {
            const int pp = idx >> 5, c4 = idx & 31, p = p0 + pp;
            f32x4 v = {0.f, 0.f, 0.f, 0.f};
            if (!smp) { if (p < TP) v = *(const f32x4*)(((float*)(F.ws + WS_P)) + (size_t)(seq * TP + p) * NINP + C_KVC + kv * 128 + c4 * 4); }
            else if (p < 2048) { const int page = ((const int*)F.ka[8])[seq * 16 + (p >> 7)]; v = *(const f32x4*)(((const float*)F.ka[4]) + (((size_t)l * NPHYS + page) * 128 + (p & 127)) * 256 + kv * 128 + c4 * 4); }
            *(LAS f32x4*)&XS[pp * 128 + c4 * 4] = v;
        }
        __syncthreads();
        const int lk = l * 2 + kv;
        float hb = ((const float*)F.ka[17])[lk * 128 + j];
#pragma unroll
        for (int ks = 0; ks < 8; ++ks) hb += ((const float*)(F.ws + WS_HBP))[(ks * 4 + lk) * 128 + j];
        float acc[4] = {hb, hb, hb, hb};
        const float* w1 = ((const float*)F.ka[16]) + (size_t)lk * 2048 * 128 + j;
        for (int s = 0; s < 32; ++s)
            for (int d = 0; d < 64; d += 4) {
                const int k = s * 64 + d;
                const float w0 = w1[(size_t)k * 128], wa = w1[(size_t)(k + 1) * 128], wb = w1[(size_t)(k + 2) * 128], wc = w1[(size_t)(k + 3) * 128];
#pragma unroll
                for (int rr = 0; rr < 4; ++rr) { const int row = rg * 4 + rr, ib = row >> 1, g = row & 1;
                    const f32x4 x = *(const LAS f32x4*)&XS[(16 * ib + s) * 128 + g * 64 + d];
                    acc[rr] += x.x * w0 + x.y * wa + x.z * wb + x.w * wc; }
            }
#pragma unroll
        for (int rr = 0; rr < 4; ++rr) H[(rg * 4 + rr) * 128 + j] = gelu_tanh(acc[rr]);
        __syncthreads();
        const float* w2 = ((const float*)F.ka[18]) + (size_t)lk * 128 * 64;
#pragma unroll
        for (int q = 0; q < 2; ++q) {
            const int idx = F.tid + q * NTHR, row = idx >> 6, e = idx & 63, ib = row >> 1, g = row & 1, i = i0 + ib;
            float o = 0.f;
            for (int jj = 0; jj < 128; ++jj) o += H[row * 128 + jj] * w2[jj * 64 + e];
            if (i < nblk) {
                if (!smp) ((float*)(F.ws + WS_CKP))[(((size_t)kv * 2 + seq) * 512 + i) * 128 + g * 64 + e] = o;
                else ((float*)(F.ws + WS_CKS))[(((size_t)kv * 128 + seq) * 128 + i) * 128 + g * 64 + e] = o;
            }
        }
    }
    __syncthreads();
}

__device__ __forceinline__ void gla_cum(Frame& F, int l, int m0, int h, LAS float* LA) {
    for (int idx = F.tid; idx < 4096; idx += NTHR) {
        const int t = idx >> 6, d = idx & 63;
        const float* ag = ((float*)(F.ws + WS_P)) + (size_t)(m0 + t) * NINP + C_AG;
        const float* wa = ((const float*)F.ka[19]) + (size_t)l * 16 * 256 + h * 64 + d;
        float a = ((const float*)F.ka[20])[l * 256 + h * 64 + d];
#pragma unroll
        for (int r = 0; r < 16; ++r) a += ag[r] * wa[r * 256];
        LA[idx] = log_sigmoid_(a) * (1.0f / 16.0f);
    }
    __syncthreads();
    if (F.tid < 64) { float c = 0.f; for (int t = 0; t < 64; ++t) { c += LA[t * 64 + F.tid]; LA[t * 64 + F.tid] = c; } }
    __syncthreads();
}

__device__ __forceinline__ void gla_g1_phase(Frame& F, int l) {
    LAS float* LA = (LAS float*)F.lds;
    LAS float* KD = LA + 4096;
    LAS float* V = KD + 4096;
    float* GKV = (float*)(F.ws + WS_GKV); float* GDEC = (float*)(F.ws + WS_GDEC);
    for (int it = F.bx; it < 1024; it += F.G) {
        const int bh = it >> 7, c = it & 127, b = bh >> 2, h = bh & 3, m0 = b * TP + c * 64;
        __syncthreads();
        gla_cum(F, l, m0, h, LA);
        for (int idx = F.tid; idx < 4096; idx += NTHR) { const int s = idx >> 6, d = idx & 63;
            KD[idx] = ((float*)(F.ws + WS_P))[(size_t)(m0 + s) * NINP + C_KG + h * 64 + d] * __expf(LA[63 * 64 + d] - LA[idx]); }
        for (int idx = F.tid; idx < 8192; idx += NTHR) { const int s = idx >> 7, e = idx & 127; V[idx] = ((float*)(F.ws + WS_P))[(size_t)(m0 + s) * NINP + C_VG + h * 128 + e]; }
        __syncthreads();
        const int d = F.tid >> 3, e0 = (F.tid & 7) * 16;
        f32x4 a0 = {0, 0, 0, 0}, a1 = a0, a2 = a0, a3 = a0;
        for (int s = 0; s < 64; ++s) { const float kd = KD[s * 64 + d]; const LAS f32x4* vv = (const LAS f32x4*)&V[s * 128 + e0];
            a0 += vv[0] * kd; a1 += vv[1] * kd; a2 += vv[2] * kd; a3 += vv[3] * kd; }
        f32x4* o = (f32x4*)(GKV + ((size_t)it * 64 + d) * 128 + e0); o[0] = a0; o[1] = a1; o[2] = a2; o[3] = a3;
        if (F.tid < 64) GDEC[(size_t)it * 64 + F.tid] = __expf(LA[63 * 64 + F.tid]);
    }
    __syncthreads();
}

__device__ __forceinline__ void gla_sample_phase(Frame& F, int l) {
    LAS float* S0 = (LAS float*)F.lds;
    LAS float* qa = S0 + 8192; LAS float* kk = qa + 64; LAS float* aa = kk + 64; LAS float* vv = aa + 64; LAS float* red = vv + 128;
    for (int it = F.bx; it < 512; it += F.G) {
        const int sb = it >> 2, h = it & 3, m = MP + sb;
        const float* pr = ((float*)(F.ws + WS_P)) + (size_t)m * NINP;
        __syncthreads();
        if (F.tid < 64) {
            const int d = F.tid;
            const float* wa = ((const float*)F.ka[19]) + (size_t)l * 16 * 256 + h * 64 + d;
            float a = ((const float*)F.ka[20])[l * 256 + h * 64 + d];
#pragma unroll
            for (int r = 0; r < 16; ++r) a += pr[C_AG + r] * wa[r * 256];
            const float dec = __expf(log_sigmoid_(a) * (1.0f / 16.0f));
            const float q = pr[C_QG + h * 64 + d] * 0.125f, k = pr[C_KG + h * 64 + d];
            qa[d] = q * dec; kk[d] = k; aa[d] = dec;
            const float qk = wave_sum(q * k);
            if (d == 0) red[0] = qk;
        } else if (F.tid < 192) vv[F.tid - 64] = pr[C_VG + h * 128 + (F.tid - 64)];
        __syncthreads();
        const float* sg = ((const float*)F.ka[7]) + (((size_t)l * MS + sb) * 4 + h) * 8192;
        float* so = F.out + O_SGLA + (((size_t)l * MS + sb) * 4 + h) * 8192;
#pragma unroll
        for (int q = 0; q < 4; ++q) {
            const int idx4 = F.tid + q * NTHR, d = idx4 >> 5, e = (idx4 & 31) * 4;
            const f32x4 s = *(const f32x4*)(sg + (size_t)idx4 * 4);
            *(LAS f32x4*)&S0[idx4 * 4] = s;
            const f32x4 v4 = *(const LAS f32x4*)&vv[e];
            *(f32x4*)(so + (size_t)idx4 * 4) = s * aa[d] + v4 * kk[d];
        }
        __syncthreads();
        float o = 0.f;
        if (F.tid < 128) {
            const int e = F.tid;
            for (int d = 0; d < 64; ++d) o += qa[d] * S0[d * 128 + e];
            o += red[0] * vv[e];
            const float ss = wave_sum(o * o);
            if (F.lane == 0) red[1 + F.wave] = ss;
        }
        __syncthreads();
        if (F.tid < 128) {
            const int e = F.tid;
            const float rstd = 1.0f / sqrtf((red[1] + red[2]) * (1.0f / 128.0f) + 1e-6f);
            const float y = o * rstd * ((const float*)F.ka[21])[l * 128 + e] * siluf_(pr[C_OG + h * 128 + e]);
            ((bf16*)(F.ws + WS_O))[(size_t)m * D + 512 + h * 128 + e] = (bf16)f2bf(y);
        }
    }
    __syncthreads();
}

__device__ __forceinline__ void gla_scan_phase(Frame& F, int l) {
    const float* GKV = (const float*)(F.ws + WS_GKV); const float* GDEC = (const float*)(F.ws + WS_GDEC); float* GS0 = (float*)(F.ws + WS_GS0);
    for (int it = F.bx; it < 128; it += F.G) {
        const int bh = it >> 4, el = (it & 15) * 512 + F.tid, d = el >> 7;
        float s = 0.f;
        for (int c = 0; c < 128; ++c) {
            const size_t base = (size_t)(bh * 128 + c);
            GS0[base * 8192 + el] = s;
            s = GDEC[base * 64 + d] * s + GKV[base * 8192 + el];
        }
        F.out[O_PGLA + ((size_t)l * 8 + bh) * 8192 + el] = s;
    }
}

__device__ __forceinline__ void gla_g3_phase(Frame& F, int l) {
    LAS float* QE = (LAS float*)F.lds;
    LAS float* KE = QE + 4096;
    LAS float* A = KE + 4096;
    LAS float* V = A + 4096;
    LAS float* S0 = V + 8192;
    LAS float* LA = S0 + 8192;
    const float* GS0 = (const float*)(F.ws + WS_GS0);
    for (int it = F.bx; it < 1024; it += F.G) {
        const int bh = it >> 7, c = it & 127, b = bh >> 2, h = bh & 3, m0 = b * TP + c * 64;
        __syncthreads();
        gla_cum(F, l, m0, h, LA);
        for (int idx = F.tid; idx < 4096; idx += NTHR) { const int t = idx >> 6, d = idx & 63; const float* pr = ((float*)(F.ws + WS_P)) + (size_t)(m0 + t) * NINP;
            const float cu = LA[idx];
            QE[idx] = pr[C_QG + h * 64 + d] * 0.125f * __expf(cu); KE[idx] = pr[C_KG + h * 64 + d] * __expf(-cu); }
        for (int idx = F.tid; idx < 8192; idx += NTHR) { const int s = idx >> 7, e = idx & 127; V[idx] = ((float*)(F.ws + WS_P))[(size_t)(m0 + s) * NINP + C_VG + h * 128 + e]; S0[idx] = GS0[(size_t)it * 8192 + idx]; }
        __syncthreads();
        {
            const int t = F.tid >> 3, s0 = (F.tid & 7) * 8;
            float a[8];
#pragma unroll
            for (int i = 0; i < 8; ++i) a[i] = 0.f;
            for (int d = 0; d < 64; d += 4) { const f32x4 q = *(const LAS f32x4*)&QE[t * 64 + d];
#pragma unroll
                for (int i = 0; i < 8; ++i) { const f32x4 k = *(const LAS f32x4*)&KE[(s0 + i) * 64 + d]; a[i] += q.x * k.x + q.y * k.y + q.z * k.z + q.w * k.w; } }
#pragma unroll
            for (int i = 0; i < 8; ++i) A[t * 64 + s0 + i] = (s0 + i <= t) ? a[i] : 0.f;
        }
        __syncthreads();
        {
            const int t = F.tid >> 3, e0 = (F.tid & 7) * 16;
            f32x4 a0 = {0, 0, 0, 0}, a1 = a0, a2 = a0, a3 = a0;
            for (int d = 0; d < 64; ++d) { const float q = QE[t * 64 + d]; const LAS f32x4* sv = (const LAS f32x4*)&S0[d * 128 + e0];
                a0 += sv[0] * q; a1 += sv[1] * q; a2 += sv[2] * q; a3 += sv[3] * q; }
            for (int s = 0; s <= t; ++s) { const float w = A[t * 64 + s]; const LAS f32x4* vv = (const LAS f32x4*)&V[s * 128 + e0];
                a0 += vv[0] * w; a1 += vv[1] * w; a2 += vv[2] * w; a3 += vv[3] * w; }
            float ss = (a0.x * a0.x + a0.y * a0.y + a0.z * a0.z + a0.w * a0.w) + (a1.x * a1.x + a1.y * a1.y + a1.z * a1.z + a1.w * a1.w)
                     + (a2.x * a2.x + a2.y * a2.y + a2.z * a2.z + a2.w * a2.w) + (a3.x * a3.x + a3.y * a3.y + a3.z * a3.z + a3.w * a3.w);
            ss += __shfl_xor(ss, 1); ss += __shfl_xor(ss, 2); ss += __shfl_xor(ss, 4);
            const float rstd = 1.0f / sqrtf(ss * (1.0f / 128.0f) + 1e-6f);
            const float* gn = ((const float*)F.ka[21]) + l * 128 + e0; const float* og = ((float*)(F.ws + WS_P)) + (size_t)(m0 + t) * NINP + C_OG + h * 128 + e0;
            float y[16]; const f32x4 av[4] = {a0, a1, a2, a3};
#pragma unroll
            for (int i = 0; i < 16; ++i) y[i] = av[i >> 2][i & 3] * rstd * gn[i] * siluf_(og[i]);
            v4u w0, w1; w0.x = pk2(y[0], y[1]); w0.y = pk2(y[2], y[3]); w0.z = pk2(y[4], y[5]); w0.w = pk2(y[6], y[7]);
            w1.x = pk2(y[8], y[9]); w1.y = pk2(y[10], y[11]); w1.z = pk2(y[12], y[13]); w1.w = pk2(y[14], y[15]);
            v4u* op = (v4u*)(((bf16*)(F.ws + WS_O)) + (size_t)(m0 + t) * D + 512 + h * 128 + e0); op[0] = w0; op[1] = w1;
        }
    }
    __syncthreads();
}
constexpr int NSA_WAVE_BYTES = 11264;
struct NsaSrc {
    const float* prow_base;
    const float* cache;
    const int* pt;
    const float* newtok;
};
template <bool SAMPLE, bool WIN>
__device__ __forceinline__ const float* nsa_kptr(const NsaSrc& s, int pos, int g) {
    if (!SAMPLE) return s.prow_base + (size_t)pos * NINP;
    if (pos >= 2048) return s.newtok;
    if (WIN) return s.cache + (size_t)(pos - 1536) * 256 + g * 64;
    const int page = s.pt[pos >> 7];
    return s.cache + ((size_t)page * 128 + (pos & 127)) * 256 + g * 64;
}
template <bool SAMPLE, bool WIN>
__device__ __forceinline__ void nsa_block(const NsaSrc& src, int pos0, int t, int g, int lane, const LAS float* Q, LAS float* PB, const float (&slope)[4],
                                          float (&mx)[4], float (&ls)[4], float (&o)[4]) {
    const int pos = pos0 + lane; const bool valid = pos >= 0 && pos <= t;
    float dot[4] = {0.f, 0.f, 0.f, 0.f};
    if (valid) {
        const f32x4* kp = (const f32x4*)nsa_kptr<SAMPLE, WIN>(src, pos, g);
#pragma unroll 4
        for (int d4 = 0; d4 < 16; ++d4) { const f32x4 k = kp[d4];
#pragma unroll
            for (int r = 0; r < 4; ++r) { const f32x4 q = *(const LAS f32x4*)&Q[r * 64 + d4 * 4]; dot[r] += q.x * k.x + q.y * k.y + q.z * k.z + q.w * k.w; } }
    }
#pragma unroll
    for (int r = 0; r < 4; ++r) {
        const float lg = valid ? dot[r] - slope[r] * (float)(t - pos) : -INFINITY;
        const float bm = wave_max(lg), mn = fmaxf(mx[r], bm);
        const float sc = __expf(mx[r] - mn), p = valid ? __expf(lg - mn) : 0.f;
        ls[r] = ls[r] * sc + wave_sum(p); o[r] *= sc; mx[r] = mn; PB[r * 64 + lane] = p;
    }
    WSYNC();
    const int k0 = pos0 < 0 ? -pos0 : 0, k1 = (t - pos0 < 63) ? (t - pos0) : 63;
    for (int kk = k0; kk <= k1; ++kk) {
        const float v = (nsa_kptr<SAMPLE, WIN>(src, pos0 + kk, g) + 128)[lane];
#pragma unroll
        for (int r = 0; r < 4; ++r) o[r] += PB[r * 64 + kk] * v;
    }
    WSYNC();
}

template <bool SAMPLE>
__device__ __forceinline__ void nsa_task(Frame& F, int l, int task, LAS unsigned char* wl) {
    const int lane = F.lane;
    LAS float* Q = (LAS float*)wl;
    LAS float* L = Q + 256;
    LAS float* PB = L + 2048;
    LAS int* SEL = (LAS int*)(PB + 256);
    const int g = task & 1; int bb, t, m;
    if (!SAMPLE) { m = task >> 1; bb = m >> 13; t = m & (TP - 1); } else { bb = task >> 1; m = MP + bb; t = 2048; }
    const float* prow = ((float*)(F.ws + WS_P)) + (size_t)m * NINP;
    float slope[4], gt[4][3];
#pragma unroll
    for (int r = 0; r < 4; ++r) { Q[r * 64 + lane] = prow[(g * 4 + r) * 64 + lane] * 0.125f; slope[r] = exp2f(-(float)(g * 4 + r + 1));
#pragma unroll
        for (int j = 0; j < 3; ++j) gt[r][j] = sigmoidf_(prow[C_GN + (g * 4 + r) * 3 + j]); }
    WSYNC();
    const int NCMAX = SAMPLE ? 127 : 511;
    int ncv = 0; if (t >= 31) { ncv = (t - 31) / 16 + 1; if (ncv > NCMAX) ncv = NCMAX; }
    const float* ck = SAMPLE ? (const float*)(F.ws + WS_CKS) + ((size_t)(0 * 128 + bb) * 128) * 128 + g * 64 : (const float*)(F.ws + WS_CKP) + ((size_t)(0 * 2 + bb) * 512) * 128 + g * 64;
    const float* cv = SAMPLE ? (const float*)(F.ws + WS_CKS) + ((size_t)(1 * 128 + bb) * 128) * 128 + g * 64 : (const float*)(F.ws + WS_CKP) + ((size_t)(1 * 2 + bb) * 512) * 128 + g * 64;
    float ocmp[4] = {0.f, 0.f, 0.f, 0.f};
    {
        float mxc[4] = {-INFINITY, -INFINITY, -INFINITY, -INFINITY};
        for (int c0 = 0; c0 < ncv; c0 += 64) {
            const int c = c0 + lane; const bool valid = c < ncv;
            float dot[4] = {0.f, 0.f, 0.f, 0.f};
            if (valid) { const f32x4* kp = (const f32x4*)(ck + (size_t)c * 128);
#pragma unroll 4
                for (int d4 = 0; d4 < 16; ++d4) { const f32x4 k = kp[d4];
#pragma unroll
                    for (int r = 0; r < 4; ++r) { const f32x4 q = *(const LAS f32x4*)&Q[r * 64 + d4 * 4]; dot[r] += q.x * k.x + q.y * k.y + q.z * k.z + q.w * k.w; } }
#pragma unroll
                for (int r = 0; r < 4; ++r) { const float lg = dot[r] - slope[r] * (float)(t - (16 * c + 31)); L[r * 512 + c] = lg; mxc[r] = fmaxf(mxc[r], lg); } }
        }
        float inv[4];
#pragma unroll
        for (int r = 0; r < 4; ++r) mxc[r] = wave_max(mxc[r]);
        WSYNC();
        float sm[4] = {0.f, 0.f, 0.f, 0.f};
        for (int c0 = 0; c0 < ncv; c0 += 64) { const int c = c0 + lane;
            if (c < ncv) {
#pragma unroll
                for (int r = 0; r < 4; ++r) { const float e = __expf(L[r * 512 + c] - mxc[r]); L[r * 512 + c] = e; sm[r] += e; } } }
#pragma unroll
        for (int r = 0; r < 4; ++r) inv[r] = 1.0f / fmaxf(wave_sum(sm[r]), 1e-30f);
        for (int c0 = 0; c0 < ncv; c0 += 64) { const int c = c0 + lane;
            if (c < ncv) {
#pragma unroll
                for (int r = 0; r < 4; ++r) L[r * 512 + c] *= inv[r]; } }
        WSYNC();
        for (int c = 0; c < ncv; ++c) { const float v = cv[(size_t)c * 128 + lane];
#pragma unroll
            for (int r = 0; r < 4; ++r) ocmp[r] += L[r * 512 + c] * v; }
    }
    const int NS = SAMPLE ? 33 : 128, cur = t >> 6;
    float sc0, sc1;
    {
        float s2[2];
#pragma unroll
        for (int q = 0; q < 2; ++q) {
            const int s = lane + 64 * q; float imp = 0.f;
            for (int c = 4 * s - 1; c <= 4 * s + 3; ++c) if (c >= 0 && c < ncv) imp += (L[c] + L[512 + c]) + (L[1024 + c] + L[1536 + c]);
            const bool forced = (s == 0) || (s == cur) || (s == cur - 1);
            float sc = (s <= cur) ? imp + (forced ? 1000.0f : 0.f) : -1e30f;
            if (s >= NS) sc = -3.0e38f;
            s2[q] = sc;
        }
        sc0 = s2[0]; sc1 = s2[1];
    }
    for (int k = 0; k < 16; ++k) {
        float best = sc0; int bi = lane;
        if (sc1 > best) { best = sc1; bi = lane + 64; }
#pragma unroll
        for (int o = 1; o < 64; o <<= 1) { const float ob = __shfl_xor(best, o); const int oi = __shfl_xor(bi, o); if (ob > best || (ob == best && oi < bi)) { best = ob; bi = oi; } }
        if (lane == 0) SEL[k] = bi;
        if (bi == lane) sc0 = -3.4e38f;
        if (bi == lane + 64) sc1 = -3.4e38f;
    }
    WSYNC();
    NsaSrc ssrc, wsrc;
    if (!SAMPLE) { ssrc.prow_base = ((float*)(F.ws + WS_P)) + (size_t)(bb * TP) * NINP + C_KVS + g * 64; wsrc.prow_base = ((float*)(F.ws + WS_P)) + (size_t)(bb * TP) * NINP + C_KVW + g * 64; ssrc.cache = wsrc.cache = nullptr; ssrc.pt = wsrc.pt = nullptr; ssrc.newtok = wsrc.newtok = nullptr; }
    else { ssrc.prow_base = wsrc.prow_base = nullptr; ssrc.cache = ((const float*)F.ka[5]) + (size_t)l * NPHYS * 128 * 256; wsrc.cache = ((const float*)F.ka[6]) + ((size_t)l * MS + bb) * 512 * 256; ssrc.pt = wsrc.pt = ((const int*)F.ka[8]) + bb * 16;
           ssrc.newtok = prow + C_KVS + g * 64; wsrc.newtok = prow + C_KVW + g * 64; }
    float oslc[4] = {0.f, 0.f, 0.f, 0.f}, owin[4] = {0.f, 0.f, 0.f, 0.f};
    {
        float mx[4] = {-INFINITY, -INFINITY, -INFINITY, -INFINITY}, ls[4] = {0.f, 0.f, 0.f, 0.f};
        for (int k = 0; k < 16; ++k) { const int s = SEL[k]; if (s > cur) continue; nsa_block<SAMPLE, false>(ssrc, 64 * s, t, g, lane, Q, PB, slope, mx, ls, oslc); }
#pragma unroll
        for (int r = 0; r < 4; ++r) oslc[r] /= fmaxf(ls[r], 1e-30f);
    }
    {
        float mx[4] = {-INFINITY, -INFINITY, -INFINITY, -INFINITY}, ls[4] = {0.f, 0.f, 0.f, 0.f};
        for (int j = 0; j < 8; ++j) { const int pos0 = t - 511 + 64 * j; if (pos0 + 63 < 0) continue; nsa_block<SAMPLE, true>(wsrc, pos0, t, g, lane, Q, PB, slope, mx, ls, owin); }
#pragma unroll
        for (int r = 0; r < 4; ++r) owin[r] /= fmaxf(ls[r], 1e-30f);
    }
#pragma unroll
    for (int r = 0; r < 4; ++r) ((bf16*)(F.ws + WS_O))[(size_t)m * D + (g * 4 + r) * 64 + lane] = (bf16)f2bf(gt[r][0] * ocmp[r] + gt[r][1] * oslc[r] + gt[r][2] * owin[r]);
}

__device__ __forceinline__ void att_phase(Frame& F, int l) {
    gla_scan_phase(F, l);
    LAS unsigned char* wl = F.lds + F.wave * NSA_WAVE_BYTES;
    for (int task = F.gw; task < 256; task += F.NGW) nsa_task<true>(F, l, task, wl);
    for (int task = F.gw; task < 2 * MP; task += F.NGW) nsa_task<false>(F, l, task, wl);
}
__global__ void __launch_bounds__(NTHR, 2) fwd_kernel(Args args) {
    extern __shared__ __attribute__((aligned(16))) unsigned char lds_raw[];
    Frame F;
    F.lds = (LAS unsigned char*)lds_raw;
    F.MISC = (volatile LAS unsigned*)(F.lds + MISC_OFF);
    F.tid = threadIdx.x; F.lane = F.tid & 63; F.wave = __builtin_amdgcn_readfirstlane(F.tid >> 6);
    F.G = gridDim.x; F.bx = blockIdx.x; F.gw = F.bx * NWAVES + F.wave; F.NGW = F.G * NWAVES;
    unsigned char* ws = args.ws; F.ws = ws; F.out = args.out;
    F.ctl = (gu32*)(ws + WS_CTL);
    F.ka = (KArgPtr)__builtin_amdgcn_kernarg_segment_ptr();
    for (int u = F.tid; u < (LDS_BYTES - RING_BYTES) / 4; u += NTHR) ((LAS unsigned*)(F.lds + RING_BYTES))[u] = 0u;
    __syncthreads();
    XcdBarrier bar = xcd_barrier_post((unsigned*)(F.ctl + CW_BAR), F.MISC + 8);
    const int lo = args.ph_lo, hi = args.ph_hi;
#define IN(k) (lo <= (k) && (k) < hi)
#define SEAM(k) do { if (IN(k) && IN((k) + 1)) xcd_barrier(bar); } while (0)

    if (IN(0)) { p0_prologue(F); } SEAM(0);
    for (int seg = 0; seg < 4; ++seg) {
        const int l = seg >> 1, second = seg & 1, pb = 1 + 12 * l + (second ? 9 : 0);
        {
            int t_ = threadIdx.x; asm volatile("" : "+v"(t_)); F.tid = t_; F.lane = t_ & 63; F.wave = __builtin_amdgcn_readfirstlane(t_ >> 6);
            unsigned char* w_ = args.ws; asm volatile("" : "+s"(w_)); F.ws = w_; ws = w_; F.ctl = (gu32*)(w_ + WS_CTL);
            float* o_ = args.out; asm volatile("" : "+s"(o_)); F.out = o_;
            int b_ = blockIdx.x; asm volatile("" : "+s"(b_)); F.bx = b_; F.gw = b_ * NWAVES + F.wave;
        }
        unsigned char* wl = ws + WS_W + (size_t)l * WL_STRIDE;
        const float* modl = ((float*)(F.ws + WS_MOD)) + (size_t)l * NMODROWS * MODW;
        if (IN(pb)) { norm_phase(F, l, second ? 2 : 0); } SEAM(pb);
        if (IN(pb + 1)) {
            pg8::Gemm g{((bf16*)(F.ws + WS_HN)), (const bf16*)(wl + (second ? WO_W3 : WO_W1)), MPAD, 2 * FF, D}; pg8::StaticOrder S; S.init(MPAD, 2 * FF, F.G, F.bx);
            EpiSwiGLU E{((bf16*)(F.ws + WS_HF))};
            pg8::gemm_phase<EpiSwiGLU, pg8::StaticOrder, true, true>(F.lds, g, S, E);
        } SEAM(pb + 1);
        if (IN(pb + 2)) {
            pg8::Gemm g{((bf16*)(F.ws + WS_HF)), (const bf16*)(wl + (second ? WO_W4 : WO_W2)), MPAD, D, FF}; pg8::StaticOrder S; S.init(MPAD, D, F.G, F.bx);
            EpiResid E{((float*)(F.ws + WS_X)), modl, (second ? 8 : 2) * D, 0.5f};
            pg8::gemm_phase<EpiResid, pg8::StaticOrder, true, true>(F.lds, g, S, E);
        } SEAM(pb + 2);
        if (!second) {
            if (IN(pb + 3)) { norm_phase(F, l, 1); } SEAM(pb + 3);
            if (IN(pb + 4)) {
                pg8::Gemm g{((bf16*)(F.ws + WS_HN)), (const bf16*)(wl + WO_WIN), MPAD, NINP, D}; pg8::StaticOrder S; S.init(MPAD, NINP, F.G, F.bx);
                EpiF32 E{((float*)(F.ws + WS_P)), NINP};
                pg8::gemm_phase<EpiF32, pg8::StaticOrder, true, true>(F.lds, g, S, E);
            } SEAM(pb + 4);
            if (IN(pb + 5)) { kv_out_phase(F, l); compress_phase(F, l); gla_g1_phase(F, l); gla_sample_phase(F, l); } SEAM(pb + 5);
            if (IN(pb + 6)) { att_phase(F, l); } SEAM(pb + 6);
            if (IN(pb + 7)) { gla_g3_phase(F, l); } SEAM(pb + 7);
            if (IN(pb + 8)) {
                pg8::Gemm g{((bf16*)(F.ws + WS_O)), (const bf16*)(wl + WO_WO), MPAD, D, D}; pg8::StaticOrder S; S.init(MPAD, D, F.G, F.bx);
                EpiResid E{((float*)(F.ws + WS_X)), modl, 5 * D, 1.0f};
                pg8::gemm_phase<EpiResid, pg8::StaticOrder, true, true>(F.lds, g, S, E);
            } SEAM(pb + 8);
        }
    }
    if (IN(25)) { final_norm_phase(F); }
#undef IN
#undef SEAM
}

extern "C" void kernel_launch(void* const* d_in, const int* in_sizes, int n_in, void* d_out, int out_size, void* d_ws, size_t ws_size, hipStream_t stream) {
    static int grid = 0;
    if (grid == 0) {
        if (n_in != 26 || out_size != (int)O_END || ws_size < WS_END) { fprintf(stderr, "kernel_launch: unexpected shapes: n_in %d out %d ws %zu\n", n_in, out_size, ws_size); grid = -1; return; }
        int dev = 0, cus = 0;
        if (hipGetDevice(&dev) != hipSuccess || hipDeviceGetAttribute(&cus, hipDeviceAttributeMultiprocessorCount, dev) != hipSuccess) { grid = -1; return; }
        if (hipFuncSetAttribute((const void*)fwd_kernel, hipFuncAttributeMaxDynamicSharedMemorySize, LDS_BYTES) != hipSuccess) { fprintf(stderr, "kernel_launch: hipFuncSetAttribute failed\n"); grid = -1; return; }
        int per_cu = 0;
        if (hipOccupancyMaxActiveBlocksPerMultiprocessor(&per_cu, (const void*)fwd_kernel, NTHR, LDS_BYTES) != hipSuccess || per_cu < 1) fprintf(stderr, "kernel_launch: occupancy query reports %d\n", per_cu);
        (void)hipGetLastError();
        grid = cus;
    }
    if (grid < 0) return;
    if (hipMemsetAsync((char*)d_ws + WS_CTL, 0, CTL_ZERO_BYTES, stream) != hipSuccess) return;
    Args a{};
    for (int i = 0; i < 26; ++i) a.in[i] = d_in[i];
    a.out = (float*)d_out; a.ws = (unsigned char*)d_ws;
#if MK_SINGLE
    a.ph_lo = 0; a.ph_hi = NPHASES;
    hipLaunchKernelGGL(fwd_kernel, dim3(grid), dim3(NTHR), LDS_BYTES, stream, a);
#else
    for (int ph = 0; ph < NPHASES; ++ph) { a.ph_lo = ph; a.ph_hi = ph + 1; hipLaunchKernelGGL(fwd_kernel, dim3(grid), dim3(NTHR), LDS_BYTES, stream, a); }
#endif
}
```

```cpp
#include <hip/hip_runtime.h>
#include <cstdio>
#include <cstdint>
#ifndef MK_SINGLE
#define MK_SINGLE 1
#endif
namespace pg8 {
#define PG8_LAS __attribute__((address_space(3)))
typedef unsigned short bf16_t;
typedef short bf16x8 __attribute__((ext_vector_type(8)));
typedef float f32x4 __attribute__((ext_vector_type(4)));
typedef unsigned u32x4 __attribute__((ext_vector_type(4)));
constexpr int BM = 256, BK = 64, HALF = 128, HTB = HALF * BK * 2  , STAGE_BYTES = 8 * HTB, NXCD = 8, WGM = 8;

__host__ __device__ __forceinline__ int lds_byte(int r, int c) { const int st = (r >> 4) * 2 + (c >> 5), rr = r & 15, cc = c & 31, ob = rr * 64 + cc * 2; return st * 1024 + (ob ^ (((ob >> 9) & 1) << 5)); }
__host__ __device__ __forceinline__ void stage_rc(int b, int& R, int& C) { const int st = b / 1024, sb = b % 1024, swz = sb ^ (((sb >> 9) & 1) << 5); R = (st >> 1) * 16 + swz / 64; C = (st & 1) * 32 + (swz % 64) / 2; }
__host__ __device__ __forceinline__ int perm32(int rho) { const int n = rho >> 4, i = rho & 15; return 8 * (i >> 2) + 4 * n + (i & 3); }

struct Unit { int pm, pn; };
struct Gemm { const bf16_t* A; const bf16_t* Bt; int M, N, K; };

struct StaticOrder {
    int nM, nN, nwg, G, c;
    __host__ __device__ void init(int M, int N, int G_, int c_) { nM = M / BM; nN = N / BM; nwg = nM * nN; G = G_; c = c_; }
    __host__ __device__ bool next(int i, Unit& u) const {
        const long L = (long)i * G + c; if (L >= nwg) return false;
        int wgid = (int)L; { const int q = nwg / NXCD, r = nwg % NXCD, xcd = wgid % NXCD, off = wgid / NXCD; wgid = (xcd < r ? xcd * (q + 1) : r * (q + 1) + (xcd - r) * q) + off; }
        const int nig = WGM * nN, gid = wgid / nig, fm = gid * WGM, gsz = (nM - fm) < WGM ? (nM - fm) : WGM;
        u.pm = fm + ((wgid % nig) % gsz); u.pn = (wgid % nig) / gsz; return true;
    }
    __device__ __forceinline__ void a_ready(const Unit&) const {}
    __device__ __forceinline__ void done(const Unit&) const {}
};

__device__ __forceinline__ unsigned cvt_pk_bf16(float lo, float hi) { unsigned r; asm volatile("v_cvt_pk_bf16_f32 %0, %1, %2" : "=v"(r) : "v"(lo), "v"(hi)); return r; }
typedef float f32x2 __attribute__((ext_vector_type(2)));
template <class Epi, class Sched, bool ALIGN_EPI = false, bool SP2 = false>
__device__ __forceinline__ void gemm_phase(PG8_LAS unsigned char* lds, const Gemm g, const Sched& S, const Epi& E) {
    int tid_ = threadIdx.x; asm volatile("" : "+v"(tid_));
    const int tid = tid_, wid = __builtin_amdgcn_readfirstlane(tid >> 6), lane = tid & 63, wr = wid >> 2, wc = wid & 3, fr = lane & 15, fq = lane >> 4;
    const int K = g.K, nt = K / BK;
    unsigned voffA[2], voffB[2];
#pragma unroll
    for (int i = 0; i < 2; ++i) { int R, C; stage_rc(tid * 16 + i * 8192, R, C); const int Rb = Epi::PERM ? ((R & ~31) + perm32(R & 31)) : R;
        voffA[i] = (unsigned)(R * K + C) * 2u; voffB[i] = (unsigned)(Rb * K + C) * 2u; }
    const size_t kstep = (size_t)(BK * 2);
    const size_t hstep = (size_t)HALF * K * 2;
    const size_t tstep = 2 * hstep;
    const unsigned ldsw = (unsigned)wid * 1024u;
    const int aoff = lds_byte(wr * 64 + fr, fq * 8), boff = lds_byte(wc * 32 + fr, fq * 8);
#define PG8_SA(b, h) (((b) * 2 + (h)) * HTB)
#define PG8_SB(b, h) ((4 + (b) * 2 + (h)) * HTB)
#define PG8_STAGE(bufoff, gbase, voff) do { _Pragma("unroll") for (int _i = 0; _i < 2; ++_i) \
        __builtin_amdgcn_global_load_lds((const unsigned*)((const char*)(gbase) + (voff)[_i]), (PG8_LAS unsigned*)(lds + (bufoff) + ldsw + _i * 8192), 16, 0, 0); } while (0)
#define PG8_LDA(dst, b, h) do { _Pragma("unroll") for (int m = 0; m < 4; ++m) _Pragma("unroll") for (int k = 0; k < 2; ++k) dst[m][k] = *(const PG8_LAS bf16x8*)(lds + PG8_SA(b, h) + aoff + m * 2048 + k * 1024); } while (0)
#define PG8_LDB(dst, b, h) do { _Pragma("unroll") for (int n = 0; n < 2; ++n) _Pragma("unroll") for (int k = 0; k < 2; ++k) dst[n][k] = *(const PG8_LAS bf16x8*)(lds + PG8_SB(b, h) + boff + n * 2048 + k * 1024); } while (0)
#define PG8_MMA(ai, bj, At, Bt) do { __builtin_amdgcn_s_setprio(1); _Pragma("unroll") for (int m = 0; m < 4; ++m) _Pragma("unroll") for (int n = 0; n < 2; ++n) _Pragma("unroll") for (int k = 0; k < 2; ++k) \
        acc[ai][bj][m][n] = __builtin_amdgcn_mfma_f32_16x16x32_bf16(Bt[n][k], At[m][k], acc[ai][bj][m][n], 0, 0, 0); __builtin_amdgcn_s_setprio(0); } while (0)
#define PG8_WAIT_V(n) asm volatile("s_waitcnt vmcnt(" #n ")" ::: "memory")
#define PG8_WAIT_L(n) asm volatile("s_waitcnt lgkmcnt(" #n ")" ::: "memory")
#define PG8_BAR __builtin_amdgcn_s_barrier()
#define PG8_SCHED __builtin_amdgcn_sched_barrier(0)
    Unit cur, nxt; int ui = 0;
    if (!S.next(0, cur)) return;
    f32x4 acc[2][2][4][2];
#pragma unroll
    for (int a = 0; a < 2; ++a)
#pragma unroll
        for (int b = 0; b < 2; ++b)
#pragma unroll
            for (int m = 0; m < 4; ++m)
#pragma unroll
                for (int n = 0; n < 2; ++n) acc[a][b][m][n] = (f32x4){0.f, 0.f, 0.f, 0.f};
    bf16x8 At[4][2], B0[2][2], B1[2][2];
    const char* cA = (const char*)g.A + (size_t)cur.pm * tstep; const char* cB = (const char*)g.Bt + (size_t)cur.pn * tstep;
    S.a_ready(cur);
    if constexpr (SP2) {
        PG8_STAGE(PG8_SB(0, 0), cB, voffB); PG8_STAGE(PG8_SB(0, 1), cB + hstep, voffB); PG8_STAGE(PG8_SA(0, 0), cA, voffA); PG8_STAGE(PG8_SA(0, 1), cA + hstep, voffA);
        if (wr == 1) PG8_BAR;
        PG8_WAIT_V(2); PG8_BAR;
        PG8_STAGE(PG8_SB(1, 0), cB + kstep, voffB); PG8_STAGE(PG8_SA(1, 0), cA + kstep, voffA); PG8_STAGE(PG8_SB(1, 1), cB + hstep + kstep, voffB);
        PG8_WAIT_V(6); PG8_BAR;
    } else {
        PG8_STAGE(PG8_SB(0, 0), cB, voffB); PG8_STAGE(PG8_SA(0, 0), cA, voffA); PG8_STAGE(PG8_SB(0, 1), cB + hstep, voffB); PG8_STAGE(PG8_SA(0, 1), cA + hstep, voffA);
        if (wr == 1) PG8_BAR;
        PG8_WAIT_V(4); PG8_BAR;
        PG8_STAGE(PG8_SB(1, 0), cB + kstep, voffB); PG8_STAGE(PG8_SA(1, 0), cA + kstep, voffA); PG8_STAGE(PG8_SB(1, 1), cB + hstep + kstep, voffB);
        PG8_WAIT_V(6); PG8_BAR;
    }
    for (;;) {
        const bool has_next = S.next(ui + 1, nxt);
        const char* nA = has_next ? (const char*)g.A + (size_t)nxt.pm * tstep : cA; const char* nB = has_next ? (const char*)g.Bt + (size_t)nxt.pn * tstep : cB;
        for (int t = 0; t < nt; t += 2) {
            const bool last = (t == nt - 2);
            const char* a1 = cA + (size_t)(t + 1) * kstep;
            const char* a2 = last ? nA : cA + (size_t)(t + 2) * kstep; const char* b2 = last ? nB : cB + (size_t)(t + 2) * kstep;
            const char* a3 = a2 + kstep; const char* b3 = b2 + kstep;
            if (last && has_next) S.a_ready(nxt);
            if constexpr (SP2) {
            PG8_LDB(B0, 0, 0); PG8_LDB(B1, 0, 1); PG8_SCHED; PG8_LDA(At, 0, 0); PG8_STAGE(PG8_SA(1, 1), a1 + hstep, voffA);
            PG8_WAIT_V(8); PG8_WAIT_L(0); PG8_BAR; PG8_MMA(0, 0, At, B0); PG8_MMA(0, 1, At, B1); PG8_BAR; PG8_SCHED;
            PG8_LDA(At, 0, 1); PG8_STAGE(PG8_SB(0, 0), b2, voffB); PG8_STAGE(PG8_SB(0, 1), b2 + hstep, voffB); PG8_STAGE(PG8_SA(0, 0), a2, voffA);
            PG8_WAIT_V(8); PG8_WAIT_L(0); PG8_BAR; PG8_MMA(1, 0, At, B0); PG8_MMA(1, 1, At, B1); PG8_BAR; PG8_SCHED;
            PG8_LDB(B0, 1, 0); PG8_LDB(B1, 1, 1); PG8_SCHED; PG8_LDA(At, 1, 0); PG8_STAGE(PG8_SA(0, 1), a2 + hstep, voffA);
            PG8_WAIT_V(8); PG8_WAIT_L(0); PG8_BAR; PG8_MMA(0, 0, At, B0); PG8_MMA(0, 1, At, B1); PG8_BAR; PG8_SCHED;
            PG8_LDA(At, 1, 1); PG8_STAGE(PG8_SB(1, 0), b3, voffB); PG8_STAGE(PG8_SB(1, 1), b3 + hstep, voffB); PG8_STAGE(PG8_SA(1, 0), a3, voffA);
            PG8_WAIT_V(8); PG8_WAIT_L(0); PG8_BAR; PG8_MMA(1, 0, At, B0); PG8_MMA(1, 1, At, B1); PG8_BAR; PG8_SCHED;
            } else {
            PG8_LDB(B0, 0, 0); PG8_SCHED; PG8_LDA(At, 0, 0); PG8_STAGE(PG8_SA(1, 1), a1 + hstep, voffA);
            PG8_WAIT_L(8); PG8_BAR; PG8_WAIT_L(0); PG8_MMA(0, 0, At, B0); PG8_BAR; PG8_SCHED;
            PG8_LDB(B1, 0, 1); PG8_STAGE(PG8_SB(0, 0), b2, voffB);
            PG8_BAR; PG8_WAIT_L(0); PG8_MMA(0, 1, At, B1); PG8_BAR;
            PG8_LDA(At, 0, 1); PG8_STAGE(PG8_SA(0, 0), a2, voffA);
            PG8_BAR; PG8_WAIT_L(0); PG8_MMA(1, 0, At, B0); PG8_BAR; PG8_SCHED;
            PG8_STAGE(PG8_SB(0, 1), b2 + hstep, voffB);
            PG8_WAIT_V(6); PG8_BAR; PG8_MMA(1, 1, At, B1); PG8_BAR;
            PG8_LDB(B0, 1, 0); PG8_SCHED; PG8_LDA(At, 1, 0); PG8_STAGE(PG8_SA(0, 1), a2 + hstep, voffA);
            PG8_WAIT_L(8); PG8_BAR; PG8_WAIT_L(0); PG8_MMA(0, 0, At, B0); PG8_BAR; PG8_SCHED;
            PG8_LDB(B1, 1, 1); PG8_STAGE(PG8_SB(1, 0), b3, voffB);
            PG8_BAR; PG8_WAIT_L(0); PG8_MMA(0, 1, At, B1); PG8_BAR;
            PG8_LDA(At, 1, 1); PG8_STAGE(PG8_SA(1, 0), a3, voffA);
            PG8_BAR; PG8_WAIT_L(0); PG8_MMA(1, 0, At, B0); PG8_BAR; PG8_SCHED;
            PG8_STAGE(PG8_SB(1, 1), b3 + hstep, voffB);
            PG8_WAIT_V(6); PG8_BAR; PG8_MMA(1, 1, At, B1); PG8_BAR;
            }
        }
        if constexpr (ALIGN_EPI) { if (wr == 0) PG8_BAR; }
        if constexpr (!Epi::AFTER_DRAIN) { E(acc, cur, wr, wc, fr, fq); S.done(cur); }
        if (!has_next) break;
#pragma unroll
        for (int a = 0; a < 2; ++a)
#pragma unroll
            for (int b = 0; b < 2; ++b)
#pragma unroll
                for (int m = 0; m < 4; ++m)
#pragma unroll
                    for (int n = 0; n < 2; ++n) acc[a][b][m][n] = (f32x4){0.f, 0.f, 0.f, 0.f};
        cur = nxt; cA = nA; cB = nB; ++ui;
        if constexpr (ALIGN_EPI) { if (wr == 1) PG8_BAR; }
    }
    PG8_WAIT_V(0);
    if constexpr (!ALIGN_EPI) { if (wr == 0) PG8_BAR; }
    PG8_BAR;
    if constexpr (Epi::AFTER_DRAIN) { E.fused(acc, cur, wr, wc, fr, fq, lds, wid, lane); S.done(cur); }
#undef PG8_SA
#undef PG8_SB
#undef PG8_STAGE
#undef PG8_LDA
#undef PG8_LDB
#undef PG8_MMA
#undef PG8_WAIT_V
#undef PG8_WAIT_L
#undef PG8_BAR
#undef PG8_SCHED
}
}
#define GAS __attribute__((address_space(1)))
#define LAS __attribute__((address_space(3)))
typedef unsigned short bf16;
typedef unsigned v4u __attribute__((ext_vector_type(4)));
typedef unsigned v2u __attribute__((ext_vector_type(2)));
typedef float f32x4 __attribute__((ext_vector_type(4)));
typedef GAS unsigned gu32;
#define RLX_AGENT __ATOMIC_RELAXED, __HIP_MEMORY_SCOPE_AGENT
#define WSYNC() asm volatile("s_waitcnt lgkmcnt(0)" ::: "memory")
__device__ __forceinline__ unsigned f2bf(float f) { unsigned u = __builtin_bit_cast(unsigned, f); return (u + 0x7fffu + ((u >> 16) & 1u)) >> 16; }
__device__ __forceinline__ unsigned pk2(float lo, float hi) { return f2bf(lo) | (f2bf(hi) << 16); }
__device__ __forceinline__ float wave_sum(float v) {
#pragma unroll
    for (int o = 1; o < 64; o <<= 1) v += __shfl_xor(v, o);
    return v;
}
__device__ __forceinline__ float wave_max(float v) {
#pragma unroll
    for (int o = 1; o < 64; o <<= 1) v = fmaxf(v, __shfl_xor(v, o));
    return v;
}
__device__ __forceinline__ float sigmoidf_(float x) { return 1.0f / (1.0f + __expf(-x)); }
__device__ __forceinline__ float siluf_(float x) { return x / (1.0f + __expf(-x)); }

constexpr int D = 1024, TP = 8192, MP = 16384, MS = 128, MTOT = 16512, MPAD = 16640;
constexpr int FF = 2816, NIN = 2856, NINP = 3072, MODW = 9216, NMODROWS = 130;
constexpr int NPHYS = 2560;
constexpr int C_KVC = 512, C_KVS = 768, C_KVW = 1024, C_GN = 1280, C_QG = 1304, C_KG = 1560, C_VG = 1816, C_AG = 2328, C_OG = 2344;
constexpr size_t O_YP = 0, O_YS = 16777216, O_PKVC = 16908288, O_PKVS = 25296896, O_PKVW = 33685504, O_PGLA = 34209792,
                 O_SKVC = 34340864, O_SKVS = 34406400, O_SKVW = 34471936, O_SGLA = 34537472, O_END = 42926080;
constexpr size_t MiB = 1u << 20;
constexpr size_t WS_CTL = 0, CTL_ZERO_BYTES = 1 * MiB;
constexpr size_t WS_W = 2 * MiB, WL_STRIDE = 42 * MiB;
constexpr size_t WO_W1 = 0, WO_W2 = 11 * MiB, WO_WIN = 11 * MiB + 5632 * 1024, WO_WO = WO_WIN + 6 * MiB, WO_W3 = WO_WO + 2 * MiB, WO_W4 = WO_W3 + 11 * MiB;
static_assert(WO_W4 + 5632 * 1024 <= WL_STRIDE, "weights");
constexpr size_t WS_MOD = 88 * MiB;
constexpr size_t WS_HBP = 98 * MiB;
constexpr size_t WS_CKP = 100 * MiB;
constexpr size_t WS_CKS = 102 * MiB;
constexpr size_t WS_X = 120 * MiB;
constexpr size_t WS_HN = 186 * MiB;
constexpr size_t WS_O = 220 * MiB;
constexpr size_t WS_HF = 256 * MiB;
constexpr size_t WS_P = 352 * MiB;
constexpr size_t WS_GKV = 548 * MiB;
constexpr size_t WS_GS0 = 580 * MiB;
constexpr size_t WS_GDEC = 612 * MiB;
constexpr size_t WS_QB = 616 * MiB;
constexpr size_t WS_KVS = 632 * MiB;
constexpr size_t WS_KVW = 640 * MiB;
constexpr size_t WS_CKB = 648 * MiB;
constexpr size_t WS_END = 650 * MiB;
constexpr int CW_BAR = 4096;
constexpr int RING_BYTES = 131072, MISC_OFF = RING_BYTES + 320, LDS_BYTES = 147456;
constexpr int NWAVES = 8, NTHR = 512;
constexpr int NPHASES = 26;

#define XB_TMO      128
#define XB_XCNT(j)  (256  + 64 * (j))
#define XB_XSUB(j)  (1280 + 64 * (j))
#define XB_XGEN(j)  (2304 + 64 * (j))
#define XB_TOP      3328
#define XB_TOPGEN   3392
#define XCD_BAR_WORDS 3456
#define XB_SPIN_CAP (1u << 18)

__device__ __forceinline__ unsigned xb_ld(unsigned* p)              { return __hip_atomic_load(p, __ATOMIC_RELAXED, __HIP_MEMORY_SCOPE_AGENT); }
__device__ __forceinline__ unsigned xb_add(unsigned* p, unsigned v) { return __hip_atomic_fetch_add(p, v, __ATOMIC_RELAXED, __HIP_MEMORY_SCOPE_AGENT); }
__device__ __forceinline__ unsigned xb_xcc_id() { return (unsigned)__builtin_amdgcn_s_getreg((3 << 11) | 20) & 0xFu; }
#define XB_SPIN(cond, bar) do { unsigned _sp = 0; while (cond) { __builtin_amdgcn_s_sleep(1); \
    if ((++_sp & 255u) == 0u) { if (xb_ld(&(bar)[XB_TMO])) break; if (_sp > XB_SPIN_CAP) { atomicAdd(&(bar)[XB_TMO], 1u); break; } } } } while (0)

struct XcdBarrier {
    unsigned* bar; unsigned x;
    volatile LAS unsigned* st;
};

__device__ __forceinline__ XcdBarrier xcd_barrier_post(unsigned* bar, volatile LAS unsigned* st) {
    XcdBarrier b; b.bar = bar; b.x = xb_xcc_id(); b.st = st;
    if (threadIdx.x == 0) (void)xb_add(&bar[XB_XCNT(b.x)], 1u);
    return b;
}
__device__ __forceinline__ void xcd_barrier_complete(unsigned* bar, unsigned x, unsigned& nloc, unsigned& nx) {
    const unsigned G = gridDim.x * gridDim.y * gridDim.z;
    unsigned sum, cnt, mine, sp = 0u;
    for (;;) {
        sum = 0u; cnt = 0u; mine = 0u;
#pragma unroll
        for (unsigned j = 0; j < 16; ++j) { const unsigned c = xb_ld(&bar[XB_XCNT(j)]); sum += c; cnt += (c > 0u) ? 1u : 0u; mine = (j == x) ? c : mine; }
        if (sum == G) break;
        __builtin_amdgcn_s_sleep(1);
        if ((++sp & 255u) == 0u) { if (xb_ld(&bar[XB_TMO])) break; if (sp > XB_SPIN_CAP) { atomicAdd(&bar[XB_TMO], 1u); break; } }
    }
    nloc = mine > 0u ? mine : 1u; nx = cnt > 0u ? cnt : 1u;
}

__device__ __forceinline__ void xcd_barrier(const XcdBarrier& b) {
    asm volatile("s_waitcnt vmcnt(0)" ::: "memory");
    __syncthreads();
    if (threadIdx.x == 0) {
        unsigned* bar = b.bar;
        __builtin_amdgcn_s_waitcnt(0);
        unsigned nloc = b.st[0], nx = b.st[1];
        if (nloc == 0u) { xcd_barrier_complete(bar, b.x, nloc, nx); b.st[0] = nloc; b.st[1] = nx; }
        const unsigned old = xb_add(&bar[XB_XSUB(b.x)], 1u);
        const unsigned gen = old / nloc;
        if (old + 1u == (gen + 1u) * nloc) {
            __builtin_amdgcn_fence(__ATOMIC_RELEASE, "agent");
            asm volatile("s_waitcnt vmcnt(0)" ::: "memory");
            const unsigned og = xb_add(&bar[XB_TOP], 1u);
            const unsigned tg = og / nx;
            if (og + 1u == (tg + 1u) * nx) xb_add(&bar[XB_TOPGEN], 1u);
            else XB_SPIN(xb_ld(&bar[XB_TOPGEN]) == tg, bar);
            __builtin_amdgcn_fence(__ATOMIC_ACQUIRE, "agent");
            xb_add(&bar[XB_XGEN(b.x)], 1u);
            asm volatile("s_waitcnt vmcnt(0)" ::: "memory");
        } else {
            XB_SPIN(xb_ld(&bar[XB_XGEN(b.x)]) == gen, bar);
            __builtin_amdgcn_fence(__ATOMIC_ACQUIRE, "agent");
            asm volatile("s_waitcnt vmcnt(0)" ::: "memory");
        }
    }
    __syncthreads();
}
typedef __attribute__((address_space(4))) const void* const volatile* KArgPtr;
struct Args { const void* in[26]; float* out; unsigned char* ws; int ph_lo, ph_hi; };
struct Frame {
    LAS unsigned char* lds;
    volatile LAS unsigned* MISC;
    gu32* ctl;
    int tid, lane, wave, G, gw, NGW;
    unsigned char* ws;
    float* out;
    int bx;
    KArgPtr ka;
};
__device__ __forceinline__ int modrow(int m) { return m < MP ? (m >> 13) : 2 + (m - MP); }

__device__ __forceinline__ void transpose_item(const float* W, int K, int N, bf16* WT, int drow0, LAS float* scr, int k0, int n0, int lane) {
#pragma unroll 8
    for (int i = 0; i < 32; ++i) { const int kk = 2 * i + (lane >> 5); const int n = n0 + (lane & 31); scr[kk * 33 + (lane & 31)] = (n < N) ? W[(size_t)(k0 + kk) * N + n] : 0.f; }
    WSYNC(); asm volatile("" ::: "memory");
    const int c = lane & 7;
#pragma unroll
    for (int j = 0; j < 4; ++j) { const int n = (lane >> 3) + 8 * j; const LAS float* s = scr + (8 * c) * 33 + n;
        v4u o; o.x = pk2(s[0 * 33], s[1 * 33]); o.y = pk2(s[2 * 33], s[3 * 33]); o.z = pk2(s[4 * 33], s[5 * 33]); o.w = pk2(s[6 * 33], s[7 * 33]);
        *(GAS v4u*)(WT + (size_t)(drow0 + n) * K + k0 + 8 * c) = o; }
    WSYNC(); asm volatile("" ::: "memory");
}
__device__ __forceinline__ int swiglu_row(int n0) { return (n0 < FF) ? (n0 / 128) * 256 + (n0 % 128) : ((n0 - FF) / 128) * 256 + 128 + ((n0 - FF) % 128); }

__device__ __forceinline__ void p0_prologue(Frame& F) {
    {
        LAS float* scr = (LAS float*)(F.lds + F.wave * 16384);
        constexpr int I1 = 16 * 176, I2 = 44 * 32, I3 = 16 * 96, I4 = 16 * 32, IL = 2 * I1 + 2 * I2 + I3 + I4;
        for (int it = F.gw; it < 2 * IL; it += F.NGW) {
            const int l = it / IL; int r = it % IL;
            unsigned char* wl = F.ws + WS_W + (size_t)l * WL_STRIDE;
            if (r < I1) { const int kb = r / 176, nb = r % 176; transpose_item(((const float*)F.ka[12]) + (size_t)l * D * 2 * FF, D, 2 * FF, (bf16*)(wl + WO_W1), swiglu_row(nb * 32), scr, kb * 64, nb * 32, F.lane); continue; } r -= I1;
            if (r < I2) { const int kb = r / 32, nb = r % 32; transpose_item(((const float*)F.ka[13]) + (size_t)l * FF * D, FF, D, (bf16*)(wl + WO_W2), nb * 32, scr, kb * 64, nb * 32, F.lane); continue; } r -= I2;
            if (r < I3) { const int kb = r / 96, nb = r % 96; transpose_item(((const float*)F.ka[14]) + (size_t)l * D * NIN, D, NIN, (bf16*)(wl + WO_WIN), nb * 32, scr, kb * 64, nb * 32, F.lane); continue; } r -= I3;
            if (r < I4) { const int kb = r / 32, nb = r % 32; transpose_item(((const float*)F.ka[22]) + (size_t)l * D * D, D, D, (bf16*)(wl + WO_WO), nb * 32, scr, kb * 64, nb * 32, F.lane); continue; } r -= I4;
            if (r < I1) { const int kb = r / 176, nb = r % 176; transpose_item(((const float*)F.ka[23]) + (size_t)l * D * 2 * FF, D, 2 * FF, (bf16*)(wl + WO_W3), swiglu_row(nb * 32), scr, kb * 64, nb * 32, F.lane); continue; } r -= I1;
            { const int kb = r / 32, nb = r % 32; transpose_item(((const float*)F.ka[24]) + (size_t)l * FF * D, FF, D, (bf16*)(wl + WO_W4), nb * 32, scr, kb * 64, nb * 32, F.lane); }
        }
    }
    for (int m = F.gw; m < MPAD; m += F.NGW) {
        const float* src = (m < MP) ? ((const float*)F.ka[0]) + (size_t)m * D : (m < MTOT ? ((const float*)F.ka[1]) + (size_t)(m - MP) * D : nullptr);
        f32x4* xo = (f32x4*)(((float*)(F.ws + WS_X)) + (size_t)m * D) + F.lane;
#pragma unroll
        for (int j = 0; j < 4; ++j) xo[64 * j] = src ? ((const f32x4*)src)[F.lane + 64 * j] : (f32x4){0.f, 0.f, 0.f, 0.f};
        if (m >= MTOT) {
            v4u z = {0u, 0u, 0u, 0u};
            v4u* h = (v4u*)(((bf16*)(F.ws + WS_HN)) + (size_t)m * D) + F.lane; h[0] = z; h[64] = z;
            v4u* o = (v4u*)(((bf16*)(F.ws + WS_O)) + (size_t)m * D) + F.lane; o[0] = z; o[64] = z;
        }
    }
    if (F.bx < 8) {
        const int ks = F.bx, lk = F.tid >> 7, j = F.tid & 127;
        const float* pe = ((const float*)F.ka[15]) + (size_t)lk * 2048 + ks * 256;
        const float* w1 = ((const float*)F.ka[16]) + (size_t)lk * 2048 * 128 + (size_t)ks * 256 * 128 + j;
        float a = 0.f;
        for (int k = 0; k < 256; ++k) a += pe[k] * w1[(size_t)k * 128];
        ((float*)(F.ws + WS_HBP))[(ks * 4 + lk) * 128 + j] = a;
    }
    {
        __syncthreads();
        LAS float* S = (LAS float*)F.lds;
        const int col = F.tid & 63, rg = F.tid >> 6, r0 = rg * 17;
        for (int slab = F.bx; slab < 288; slab += F.G) {
            const int l = slab / 144, e0 = (slab % 144) * 64;
            const float* W = ((const float*)F.ka[9]) + (size_t)l * D * MODW + e0 + col;
            float acc[17];
#pragma unroll
            for (int j = 0; j < 17; ++j) acc[j] = 0.f;
            for (int d0 = 0; d0 < D; d0 += 128) {
                __syncthreads();
                for (int idx = F.tid; idx < 136 * 128; idx += NTHR) {
                    const int r = idx >> 7, dd = idx & 127;
                    float v = 0.f;
                    if (r < 2) v = ((const float*)F.ka[2])[r * D + d0 + dd]; else if (r < NMODROWS) v = ((const float*)F.ka[3])[(r - 2) * D + d0 + dd];
                    S[idx] = siluf_(v);
                }
                __syncthreads();
                for (int dd = 0; dd < 128; dd += 4) {
                    const float w0 = W[(size_t)(d0 + dd) * MODW], w1 = W[(size_t)(d0 + dd + 1) * MODW], w2 = W[(size_t)(d0 + dd + 2) * MODW], w3 = W[(size_t)(d0 + dd + 3) * MODW];
#pragma unroll
                    for (int j = 0; j < 17; ++j) { const f32x4 s = *(const LAS f32x4*)&S[(r0 + j) * 128 + dd]; acc[j] += s.x * w0 + s.y * w1 + s.z * w2 + s.w * w3; }
                }
            }
            const float bb = ((const float*)F.ka[10])[(size_t)l * MODW + e0 + col];
#pragma unroll
            for (int j = 0; j < 17; ++j) { const int r = r0 + j; if (r < NMODROWS) ((float*)(F.ws + WS_MOD))[((size_t)l * NMODROWS + r) * MODW + e0 + col] = acc[j] + bb; }
        }
        __syncthreads();
    }
}

__device__ __forceinline__ void norm_phase(Frame& F, int l, int sub) {
    const float* gvec = ((const float*)F.ka[11]) + ((size_t)l * 3 + sub) * D;
    for (int m = F.gw; m < MTOT; m += F.NGW) {
        const f32x4* xr = (const f32x4*)(((float*)(F.ws + WS_X)) + (size_t)m * D) + F.lane;
        f32x4 v[4]; float s = 0.f;
#pragma unroll
        for (int j = 0; j < 4; ++j) { v[j] = xr[64 * j]; s += (v[j].x * v[j].x + v[j].y * v[j].y) + (v[j].z * v[j].z + v[j].w * v[j].w); }
        const float rstd = 1.0f / sqrtf(wave_sum(s) * (1.0f / D) + 1e-6f);
        const float* mrow = ((float*)(F.ws + WS_MOD)) + ((size_t)l * NMODROWS + modrow(m)) * MODW + (size_t)(3 * sub) * D;
        v2u* o8 = (v2u*)(((bf16*)(F.ws + WS_HN)) + (size_t)m * D) + F.lane;
#pragma unroll
        for (int j = 0; j < 4; ++j) {
            const int c = 4 * F.lane + 256 * j;
            const f32x4 g = *(const f32x4*)(gvec + c), sh = *(const f32x4*)(mrow + c), sc = *(const f32x4*)(mrow + D + c);
            const f32x4 h = (v[j] * rstd * g) * (sc + 1.0f) + sh;
            v2u w; w.x = pk2(h.x, h.y); w.y = pk2(h.z, h.w); o8[64 * j] = w;
        }
    }
}
__device__ __forceinline__ void final_norm_phase(Frame& F) {
    for (int m = F.gw; m < MTOT; m += F.NGW) {
        const f32x4* xr = (const f32x4*)(((float*)(F.ws + WS_X)) + (size_t)m * D) + F.lane;
        f32x4 v[4]; float s = 0.f;
#pragma unroll
        for (int j = 0; j < 4; ++j) { v[j] = xr[64 * j]; s += (v[j].x * v[j].x + v[j].y * v[j].y) + (v[j].z * v[j].z + v[j].w * v[j].w); }
        const float rstd = 1.0f / sqrtf(wave_sum(s) * (1.0f / D) + 1e-6f);
        float* orow = (m < MP) ? F.out + O_YP + (size_t)m * D : F.out + O_YS + (size_t)(m - MP) * D;
#pragma unroll
        for (int j = 0; j < 4; ++j) { const int c = 4 * F.lane + 256 * j; const f32x4 g = *(const f32x4*)(((const float*)F.ka[25]) + c); *(f32x4*)(orow + c) = v[j] * rstd * g; }
    }
}

struct EpiSwiGLU {
    static constexpr bool PERM = true, AFTER_DRAIN = false;
    bf16* HFp;
    __device__ __forceinline__ void operator()(const pg8::f32x4 (&acc)[2][2][4][2], const pg8::Unit& u, int wr, int wc, int fr, int fq) const {
        const int row0 = u.pm * 256 + wr * 64 + fr, col0 = u.pn * 128 + wc * 32 + 8 * fq;
#pragma unroll
        for (int ai = 0; ai < 2; ++ai)
#pragma unroll
            for (int m = 0; m < 4; ++m) {
                const pg8::f32x4 g0 = acc[ai][0][m][0], g1 = acc[ai][0][m][1], u0 = acc[ai][1][m][0], u1 = acc[ai][1][m][1];
                pg8::u32x4 w;
                w.x = pg8::cvt_pk_bf16(siluf_(g0[0]) * u0[0], siluf_(g0[1]) * u0[1]); w.y = pg8::cvt_pk_bf16(siluf_(g0[2]) * u0[2], siluf_(g0[3]) * u0[3]);
                w.z = pg8::cvt_pk_bf16(siluf_(g1[0]) * u1[0], siluf_(g1[1]) * u1[1]); w.w = pg8::cvt_pk_bf16(siluf_(g1[2]) * u1[2], siluf_(g1[3]) * u1[3]);
                *(pg8::u32x4*)(HFp + (size_t)(row0 + ai * 128 + m * 16) * FF + col0) = w;
            }
    }
};
struct EpiResid {
    static constexpr bool PERM = false, AFTER_DRAIN = false;
    float* Xp; const float* modl; int gofs; float coef;
    __device__ __forceinline__ void operator()(const pg8::f32x4 (&acc)[2][2][4][2], const pg8::Unit& u, int wr, int wc, int fr, int fq) const {
#pragma unroll
        for (int ai = 0; ai < 2; ++ai)
#pragma unroll
            for (int m = 0; m < 4; ++m) {
                const int row = u.pm * 256 + ai * 128 + wr * 64 + m * 16 + fr;
                if (row < MTOT) {
                    const float* g = modl + (size_t)modrow(row) * MODW + gofs; float* xr = Xp + (size_t)row * D;
#pragma unroll
                    for (int bj = 0; bj < 2; ++bj)
#pragma unroll
                        for (int n = 0; n < 2; ++n) {
                            const int col = u.pn * 256 + bj * 128 + wc * 32 + n * 16 + fq * 4;
                            const pg8::f32x4 gv = *(const pg8::f32x4*)(g + col); pg8::f32x4 xv = *(pg8::f32x4*)(xr + col);
                            xv += gv * acc[ai][bj][m][n] * coef; *(pg8::f32x4*)(xr + col) = xv;
                        }
                }
            }
    }
};
struct EpiF32 {
    static constexpr bool PERM = false, AFTER_DRAIN = false;
    float* Pp; int ldc;
    __device__ __forceinline__ void operator()(const pg8::f32x4 (&acc)[2][2][4][2], const pg8::Unit& u, int wr, int wc, int fr, int fq) const {
#pragma unroll
        for (int ai = 0; ai < 2; ++ai)
#pragma unroll
            for (int m = 0; m < 4; ++m) {
                float* pr = Pp + (size_t)(u.pm * 256 + ai * 128 + wr * 64 + m * 16 + fr) * ldc;
#pragma unroll
                for (int bj = 0; bj < 2; ++bj)
#pragma unroll
                    for (int n = 0; n < 2; ++n) *(pg8::f32x4*)(pr + u.pn * 256 + bj * 128 + wc * 32 + n * 16 + fq * 4) = acc[ai][bj][m][n];
            }
    }
};
__device__ __forceinline__ float gelu_tanh(float x) { const float u = 0.7978845608028654f * (x + 0.044715f * x * x * x); return 0.5f * x * (1.0f + tanhf(u)); }
__device__ __forceinline__ float log_sigmoid_(float a) { return fminf(a, 0.f) - log1pf(__expf(-fabsf(a))); }

__device__ __forceinline__ float nsa_qscale() { return 0.125f * 1.4426950408889634f; }
__device__ __forceinline__ void kv_out_phase(Frame& F, int l) {
    for (int m = F.gw; m < MTOT; m += F.NGW) {
        const f32x4* pr = (const f32x4*)(((float*)(F.ws + WS_P)) + (size_t)m * NINP);
        const f32x4 a = pr[C_KVC / 4 + F.lane], b = pr[C_KVS / 4 + F.lane], c = pr[C_KVW / 4 + F.lane];
        if (m < MP) {
            { v2u w; w.x = pk2(b.x, b.y); w.y = pk2(b.z, b.w); ((v2u*)(F.ws + WS_KVS + (size_t)m * 512))[F.lane] = w; }
            { v2u w; w.x = pk2(c.x, c.y); w.y = pk2(c.z, c.w); ((v2u*)(F.ws + WS_KVW + (size_t)m * 512))[F.lane] = w; }
            { const f32x4 q0 = pr[2 * F.lane] * nsa_qscale(), q1 = pr[2 * F.lane + 1] * nsa_qscale(); v4u w; w.x = pk2(q0.x, q0.y); w.y = pk2(q0.z, q0.w); w.z = pk2(q1.x, q1.y); w.w = pk2(q1.z, q1.w);
              ((v4u*)(F.ws + WS_QB + (size_t)m * 1024))[F.lane] = w; }
            ((f32x4*)(F.out + O_PKVC + ((size_t)l * MP + m) * 256))[F.lane] = a;
            ((f32x4*)(F.out + O_PKVS + ((size_t)l * MP + m) * 256))[F.lane] = b;
            const int t = m & (TP - 1), bb = m >> 13;
            if (t >= TP - 512) ((f32x4*)(F.out + O_PKVW + ((size_t)(l * 2 + bb) * 512 + (t - (TP - 512))) * 256))[F.lane] = c;
        } else {
            const int sb = m - MP;
            ((f32x4*)(F.out + O_SKVC + ((size_t)l * MS + sb) * 256))[F.lane] = a;
            ((f32x4*)(F.out + O_SKVS + ((size_t)l * MS + sb) * 256))[F.lane] = b;
            ((f32x4*)(F.out + O_SKVW + ((size_t)l * MS + sb) * 256))[F.lane] = c;
        }
    }
}

__device__ __forceinline__ void compress_phase(Frame& F, int l) {
    LAS float* XS = (LAS float*)F.lds;
    LAS float* H = (LAS float*)(F.lds + 144 * 128 * 4);
    const int j = F.tid & 127, rg = F.tid >> 7;
    for (int it = F.bx; it < 256 + 4096; it += F.G) {
        int seq, kv, ig; const bool smp = it >= 256;
        if (!smp) { seq = it >> 7; kv = (it >> 6) & 1; ig = it & 63; } else { const int r = it - 256; seq = r >> 5; kv = (r >> 4) & 1; ig = r & 15; }
        const int i0 = ig * 8, p0 = i0 * 16, nblk = smp ? 127 : 511;
        __syncthreads();
        for (int idx = F.tid; idx < 144 * 32; idx += NTHR) {
            const int pp = idx >> 5, c4 = idx & 31, p = p0 + pp;
            f32x4 v = {0.f, 0.f, 0.f, 0.f};
            if (!smp) { if (p < TP) v = *(const f32x4*)(((float*)(F.ws + WS_P)) + (size_t)(seq * TP + p) * NINP + C_KVC + kv * 128 + c4 * 4); }
            else if (p < 2048) { const int page = ((const int*)F.ka[8])[seq * 16 + (p >> 7)]; v = *(const f32x4*)(((const float*)F.ka[4]) + (((size_t)l * NPHYS + page) * 128 + (p & 127)) * 256 + kv * 128 + c4 * 4); }
            *(LAS f32x4*)&XS[pp * 128 + c4 * 4] = v;
        }
        __syncthreads();
        const int lk = l * 2 + kv;
        float hb = ((const float*)F.ka[17])[lk * 128 + j];
#pragma unroll
        for (int ks = 0; ks < 8; ++ks) hb += ((const float*)(F.ws + WS_HBP))[(ks * 4 + lk) * 128 + j];
        float acc[4] = {hb, hb, hb, hb};
        const float* w1 = ((const float*)F.ka[16]) + (size_t)lk * 2048 * 128 + j;
        for (int s = 0; s < 32; ++s)
            for (int d = 0; d < 64; d += 4) {
                const int k = s * 64 + d;
                const float w0 = w1[(size_t)k * 128], wa = w1[(size_t)(k + 1) * 128], wb = w1[(size_t)(k + 2) * 128], wc = w1[(size_t)(k + 3) * 128];
#pragma unroll
                for (int rr = 0; rr < 4; ++rr) { const int row = rg * 4 + rr, ib = row >> 1, g = row & 1;
                    const f32x4 x = *(const LAS f32x4*)&XS[(16 * ib + s) * 128 + g * 64 + d];
                    acc[rr] += x.x * w0 + x.y * wa + x.z * wb + x.w * wc; }
            }
#pragma unroll
        for (int rr = 0; rr < 4; ++rr) H[(rg * 4 + rr) * 128 + j] = gelu_tanh(acc[rr]);
        __syncthreads();
        const float* w2 = ((const float*)F.ka[18]) + (size_t)lk * 128 * 64;
#pragma unroll
        for (int q = 0; q < 2; ++q) {
            const int idx = F.tid + q * NTHR, row = idx >> 6, e = idx & 63, ib = row >> 1, g = row & 1, i = i0 + ib;
            float o = 0.f;
            for (int jj = 0; jj < 128; ++jj) o += H[row * 128 + jj] * w2[jj * 64 + e];
            if (!smp) ((bf16*)(F.ws + WS_CKB))[(((size_t)kv * 2 + seq) * 512 + i) * 128 + g * 64 + e] = (bf16)f2bf(i < nblk ? o : 0.f);
            if (i < nblk) {
                if (!smp) ((float*)(F.ws + WS_CKP))[(((size_t)kv * 2 + seq) * 512 + i) * 128 + g * 64 + e] = o;
                else ((float*)(F.ws + WS_CKS))[(((size_t)kv * 128 + seq) * 128 + i) * 128 + g * 64 + e] = o;
            }
        }
    }
    __syncthreads();
}

__device__ __forceinline__ void gla_cum(Frame& F, int l, int m0, int h, LAS float* LA) {
    for (int idx = F.tid; idx < 4096; idx += NTHR) {
        const int t = idx >> 6, d = idx & 63;
        const float* ag = ((float*)(F.ws + WS_P)) + (size_t)(m0 + t) * NINP + C_AG;
        const float* wa = ((const float*)F.ka[19]) + (size_t)l * 16 * 256 + h * 64 + d;
        float a = ((const float*)F.ka[20])[l * 256 + h * 64 + d];
#pragma unroll
        for (int r = 0; r < 16; ++r) a += ag[r] * wa[r * 256];
        LA[idx] = log_sigmoid_(a) * (1.0f / 16.0f);
    }
    __syncthreads();
    if (F.tid < 64) { float c = 0.f; for (int t = 0; t < 64; ++t) { c += LA[t * 64 + F.tid]; LA[t * 64 + F.tid] = c; } }
    __syncthreads();
}

__device__ __forceinline__ void gla_g1_phase(Frame& F, int l) {
    LAS float* LA = (LAS float*)F.lds;
    LAS float* KD = LA + 4096;
    LAS float* V = KD + 4096;
    float* GKV = (float*)(F.ws + WS_GKV); float* GDEC = (float*)(F.ws + WS_GDEC);
    for (int it = F.bx; it < 1024; it += F.G) {
        const int bh = it >> 7, c = it & 127, b = bh >> 2, h = bh & 3, m0 = b * TP + c * 64;
        __syncthreads();
        gla_cum(F, l, m0, h, LA);
        for (int idx = F.tid; idx < 4096; idx += NTHR) { const int s = idx >> 6, d = idx & 63;
            KD[idx] = ((float*)(F.ws + WS_P))[(size_t)(m0 + s) * NINP + C_KG + h * 64 + d] * __expf(LA[63 * 64 + d] - LA[idx]); }
        for (int idx = F.tid; idx < 8192; idx += NTHR) { const int s = idx >> 7, e = idx & 127; V[idx] = ((float*)(F.ws + WS_P))[(size_t)(m0 + s) * NINP + C_VG + h * 128 + e]; }
        __syncthreads();
        const int d = F.tid >> 3, e0 = (F.tid & 7) * 16;
        f32x4 a0 = {0, 0, 0, 0}, a1 = a0, a2 = a0, a3 = a0;
        for (int s = 0; s < 64; ++s) { const float kd = KD[s * 64 + d]; const LAS f32x4* vv = (const LAS f32x4*)&V[s * 128 + e0];
            a0 += vv[0] * kd; a1 += vv[1] * kd; a2 += vv[2] * kd; a3 += vv[3] * kd; }
        f32x4* o = (f32x4*)(GKV + ((size_t)it * 64 + d) * 128 + e0); o[0] = a0; o[1] = a1; o[2] = a2; o[3] = a3;
        if (F.tid < 64) GDEC[(size_t)it * 64 + F.tid] = __expf(LA[63 * 64 + F.tid]);
    }
    __syncthreads();
}

__device__ __forceinline__ void gla_sample_phase(Frame& F, int l) {
    LAS float* S0 = (LAS float*)F.lds;
    LAS float* qa = S0 + 8192; LAS float* kk = qa + 64; LAS float* aa = kk + 64; LAS float* vv = aa + 64; LAS float* red = vv + 128;
    for (int it = F.bx; it < 512; it += F.G) {
        const int sb = it >> 2, h = it & 3, m = MP + sb;
        const float* pr = ((float*)(F.ws + WS_P)) + (size_t)m * NINP;
        __syncthreads();
        if (F.tid < 64) {
            const int d = F.tid;
            const float* wa = ((const float*)F.ka[19]) + (size_t)l * 16 * 256 + h * 64 + d;
            float a = ((const float*)F.ka[20])[l * 256 + h * 64 + d];
#pragma unroll
            for (int r = 0; r < 16; ++r) a += pr[C_AG + r] * wa[r * 256];
            const float dec = __expf(log_sigmoid_(a) * (1.0f / 16.0f));
            const float q = pr[C_QG + h * 64 + d] * 0.125f, k = pr[C_KG + h * 64 + d];
            qa[d] = q * dec; kk[d] = k; aa[d] = dec;
            const float qk = wave_sum(q * k);
            if (d == 0) red[0] = qk;
        } else if (F.tid < 192) vv[F.tid - 64] = pr[C_VG + h * 128 + (F.tid - 64)];
        __syncthreads();
        const float* sg = ((const float*)F.ka[7]) + (((size_t)l * MS + sb) * 4 + h) * 8192;
        float* so = F.out + O_SGLA + (((size_t)l * MS + sb) * 4 + h) * 8192;
#pragma unroll
        for (int q = 0; q < 4; ++q) {
            const int idx4 = F.tid + q * NTHR, d = idx4 >> 5, e = (idx4 & 31) * 4;
            const f32x4 s = *(const f32x4*)(sg + (size_t)idx4 * 4);
            *(LAS f32x4*)&S0[idx4 * 4] = s;
            const f32x4 v4 = *(const LAS f32x4*)&vv[e];
            *(f32x4*)(so + (size_t)idx4 * 4) = s * aa[d] + v4 * kk[d];
        }
        __syncthreads();
        float o = 0.f;
        if (F.tid < 128) {
            const int e = F.tid;
            for (int d = 0; d < 64; ++d) o += qa[d] * S0[d * 128 + e];
            o += red[0] * vv[e];
            const float ss = wave_sum(o * o);
            if (F.lane == 0) red[1 + F.wave] = ss;
        }
        __syncthreads();
        if (F.tid < 128) {
            const int e = F.tid;
            const float rstd = 1.0f / sqrtf((red[1] + red[2]) * (1.0f / 128.0f) + 1e-6f);
            const float y = o * rstd * ((const float*)F.ka[21])[l * 128 + e] * siluf_(pr[C_OG + h * 128 + e]);
            ((bf16*)(F.ws + WS_O))[(size_t)m * D + 512 + h * 128 + e] = (bf16)f2bf(y);
        }
    }
    __syncthreads();
}

__device__ __forceinline__ void gla_scan_phase(Frame& F, int l) {
    const float* GKV = (const float*)(F.ws + WS_GKV); const float* GDEC = (const float*)(F.ws + WS_GDEC); float* GS0 = (float*)(F.ws + WS_GS0);
    for (int it = F.bx; it < 128; it += F.G) {
        const int bh = it >> 4, el = (it & 15) * 512 + F.tid, d = el >> 7;
        float s = 0.f;
        for (int c = 0; c < 128; ++c) {
            const size_t base = (size_t)(bh * 128 + c);
            GS0[base * 8192 + el] = s;
            s = GDEC[base * 64 + d] * s + GKV[base * 8192 + el];
        }
        F.out[O_PGLA + ((size_t)l * 8 + bh) * 8192 + el] = s;
    }
}

__device__ __forceinline__ void gla_g3_phase(Frame& F, int l) {
    LAS float* QE = (LAS float*)F.lds;
    LAS float* KE = QE + 4096;
    LAS float* A = KE + 4096;
    LAS float* V = A + 4096;
    LAS float* S0 = V + 8192;
    LAS float* LA = S0 + 8192;
    const float* GS0 = (const float*)(F.ws + WS_GS0);
    for (int it = F.bx; it < 1024; it += F.G) {
        const int bh = it >> 7, c = it & 127, b = bh >> 2, h = bh & 3, m0 = b * TP + c * 64;
        __syncthreads();
        gla_cum(F, l, m0, h, LA);
        for (int idx = F.tid; idx < 4096; idx += NTHR) { const int t = idx >> 6, d = idx & 63; const float* pr = ((float*)(F.ws + WS_P)) + (size_t)(m0 + t) * NINP;
            const float cu = LA[idx];
            QE[idx] = pr[C_QG + h * 64 + d] * 0.125f * __expf(cu); KE[idx] = pr[C_KG + h * 64 + d] * __expf(-cu); }
        for (int idx = F.tid; idx < 8192; idx += NTHR) { const int s = idx >> 7, e = idx & 127; V[idx] = ((float*)(F.ws + WS_P))[(size_t)(m0 + s) * NINP + C_VG + h * 128 + e]; S0[idx] = GS0[(size_t)it * 8192 + idx]; }
        __syncthreads();
        {
            const int t = F.tid >> 3, s0 = (F.tid & 7) * 8;
            float a[8];
#pragma unroll
            for (int i = 0; i < 8; ++i) a[i] = 0.f;
            for (int d = 0; d < 64; d += 4) { const f32x4 q = *(const LAS f32x4*)&QE[t * 64 + d];
#pragma unroll
                for (int i = 0; i < 8; ++i) { const f32x4 k = *(const LAS f32x4*)&KE[(s0 + i) * 64 + d]; a[i] += q.x * k.x + q.y * k.y + q.z * k.z + q.w * k.w; } }
#pragma unroll
            for (int i = 0; i < 8; ++i) A[t * 64 + s0 + i] = (s0 + i <= t) ? a[i] : 0.f;
        }
        __syncthreads();
        {
            const int t = F.tid >> 3, e0 = (F.tid & 7) * 16;
            f32x4 a0 = {0, 0, 0, 0}, a1 = a0, a2 = a0, a3 = a0;
            for (int d = 0; d < 64; ++d) { const float q = QE[t * 64 + d]; const LAS f32x4* sv = (const LAS f32x4*)&S0[d * 128 + e0];
                a0 += sv[0] * q; a1 += sv[1] * q; a2 += sv[2] * q; a3 += sv[3] * q; }
            for (int s = 0; s <= t; ++s) { const float w = A[t * 64 + s]; const LAS f32x4* vv = (const LAS f32x4*)&V[s * 128 + e0];
                a0 += vv[0] * w; a1 += vv[1] * w; a2 += vv[2] * w; a3 += vv[3] * w; }
            float ss = (a0.x * a0.x + a0.y * a0.y + a0.z * a0.z + a0.w * a0.w) + (a1.x * a1.x + a1.y * a1.y + a1.z * a1.z + a1.w * a1.w)
                     + (a2.x * a2.x + a2.y * a2.y + a2.z * a2.z + a2.w * a2.w) + (a3.x * a3.x + a3.y * a3.y + a3.z * a3.z + a3.w * a3.w);
            ss += __shfl_xor(ss, 1); ss += __shfl_xor(ss, 2); ss += __shfl_xor(ss, 4);
            const float rstd = 1.0f / sqrtf(ss * (1.0f / 128.0f) + 1e-6f);
            const float* gn = ((const float*)F.ka[21]) + l * 128 + e0; const float* og = ((float*)(F.ws + WS_P)) + (size_t)(m0 + t) * NINP + C_OG + h * 128 + e0;
            float y[16]; const f32x4 av[4] = {a0, a1, a2, a3};
#pragma unroll
            for (int i = 0; i < 16; ++i) y[i] = av[i >> 2][i & 3] * rstd * gn[i] * siluf_(og[i]);
            v4u w0, w1; w0.x = pk2(y[0], y[1]); w0.y = pk2(y[2], y[3]); w0.z = pk2(y[4], y[5]); w0.w = pk2(y[6], y[7]);
            w1.x = pk2(y[8], y[9]); w1.y = pk2(y[10], y[11]); w1.z = pk2(y[12], y[13]); w1.w = pk2(y[14], y[15]);
            v4u* op = (v4u*)(((bf16*)(F.ws + WS_O)) + (size_t)(m0 + t) * D + 512 + h * 128 + e0); op[0] = w0; op[1] = w1;
        }
    }
    __syncthreads();
}
constexpr int NSA_WAVE_BYTES = 11264;
struct NsaSrc {
    const float* prow_base;
    const float* cache;
    const int* pt;
    const float* newtok;
};
template <bool SAMPLE, bool WIN>
__device__ __forceinline__ const float* nsa_kptr(const NsaSrc& s, int pos, int g) {
    if (!SAMPLE) return s.prow_base + (size_t)pos * NINP;
    if (pos >= 2048) return s.newtok;
    if (WIN) return s.cache + (size_t)(pos - 1536) * 256 + g * 64;
    const int page = s.pt[pos >> 7];
    return s.cache + ((size_t)page * 128 + (pos & 127)) * 256 + g * 64;
}
template <bool SAMPLE, bool WIN>
__device__ __forceinline__ void nsa_block(const NsaSrc& src, int pos0, int t, int g, int lane, const LAS float* Q, LAS float* PB, const float (&slope)[4],
                                          float (&mx)[4], float (&ls)[4], float (&o)[4]) {
    const int pos = pos0 + lane; const bool valid = pos >= 0 && pos <= t;
    float dot[4] = {0.f, 0.f, 0.f, 0.f};
    if (valid) {
        const f32x4* kp = (const f32x4*)nsa_kptr<SAMPLE, WIN>(src, pos, g);
#pragma unroll 4
        for (int d4 = 0; d4 < 16; ++d4) { const f32x4 k = kp[d4];
#pragma unroll
            for (int r = 0; r < 4; ++r) { const f32x4 q = *(const LAS f32x4*)&Q[r * 64 + d4 * 4]; dot[r] += q.x * k.x + q.y * k.y + q.z * k.z + q.w * k.w; } }
    }
#pragma unroll
    for (int r = 0; r < 4; ++r) {
        const float lg = valid ? dot[r] - slope[r] * (float)(t - pos) : -INFINITY;
        const float bm = wave_max(lg), mn = fmaxf(mx[r], bm);
        const float sc = __expf(mx[r] - mn), p = valid ? __expf(lg - mn) : 0.f;
        ls[r] = ls[r] * sc + wave_sum(p); o[r] *= sc; mx[r] = mn; PB[r * 64 + lane] = p;
    }
    WSYNC();
    const int k0 = pos0 < 0 ? -pos0 : 0, k1 = (t - pos0 < 63) ? (t - pos0) : 63;
    for (int kk = k0; kk <= k1; ++kk) {
        const float v = (nsa_kptr<SAMPLE, WIN>(src, pos0 + kk, g) + 128)[lane];
#pragma unroll
        for (int r = 0; r < 4; ++r) o[r] += PB[r * 64 + kk] * v;
    }
    WSYNC();
}

template <bool SAMPLE>
__device__ __forceinline__ void nsa_task(Frame& F, int l, int task, LAS unsigned char* wl) {
    const int lane = F.lane;
    LAS float* Q = (LAS float*)wl;
    LAS float* L = Q + 256;
    LAS float* PB = L + 2048;
    LAS int* SEL = (LAS int*)(PB + 256);
    const int g = task & 1; int bb, t, m;
    if (!SAMPLE) { m = task >> 1; bb = m >> 13; t = m & (TP - 1); } else { bb = task >> 1; m = MP + bb; t = 2048; }
    const float* prow = ((float*)(F.ws + WS_P)) + (size_t)m * NINP;
    float slope[4], gt[4][3];
#pragma unroll
    for (int r = 0; r < 4; ++r) { Q[r * 64 + lane] = prow[(g * 4 + r) * 64 + lane] * 0.125f; slope[r] = exp2f(-(float)(g * 4 + r + 1));
#pragma unroll
        for (int j = 0; j < 3; ++j) gt[r][j] = sigmoidf_(prow[C_GN + (g * 4 + r) * 3 + j]); }
    WSYNC();
    const int NCMAX = SAMPLE ? 127 : 511;
    int ncv = 0; if (t >= 31) { ncv = (t - 31) / 16 + 1; if (ncv > NCMAX) ncv = NCMAX; }
    const float* ck = SAMPLE ? (const float*)(F.ws + WS_CKS) + ((size_t)(0 * 128 + bb) * 128) * 128 + g * 64 : (const float*)(F.ws + WS_CKP) + ((size_t)(0 * 2 + bb) * 512) * 128 + g * 64;
    const float* cv = SAMPLE ? (const float*)(F.ws + WS_CKS) + ((size_t)(1 * 128 + bb) * 128) * 128 + g * 64 : (const float*)(F.ws + WS_CKP) + ((size_t)(1 * 2 + bb) * 512) * 128 + g * 64;
    float ocmp[4] = {0.f, 0.f, 0.f, 0.f};
    {
        float mxc[4] = {-INFINITY, -INFINITY, -INFINITY, -INFINITY};
        for (int c0 = 0; c0 < ncv; c0 += 64) {
            const int c = c0 + lane; const bool valid = c < ncv;
            float dot[4] = {0.f, 0.f, 0.f, 0.f};
            if (valid) { const f32x4* kp = (const f32x4*)(ck + (size_t)c * 128);
#pragma unroll 4
                for (int d4 = 0; d4 < 16; ++d4) { const f32x4 k = kp[d4];
#pragma unroll
                    for (int r = 0; r < 4; ++r) { const f32x4 q = *(const LAS f32x4*)&Q[r * 64 + d4 * 4]; dot[r] += q.x * k.x + q.y * k.y + q.z * k.z + q.w * k.w; } }
#pragma unroll
                for (int r = 0; r < 4; ++r) { const float lg = dot[r] - slope[r] * (float)(t - (16 * c + 31)); L[r * 512 + c] = lg; mxc[r] = fmaxf(mxc[r], lg); } }
        }
        float inv[4];
#pragma unroll
        for (int r = 0; r < 4; ++r) mxc[r] = wave_max(mxc[r]);
        WSYNC();
        float sm[4] = {0.f, 0.f, 0.f, 0.f};
        for (int c0 = 0; c0 < ncv; c0 += 64) { const int c = c0 + lane;
            if (c < ncv) {
#pragma unroll
                for (int r = 0; r < 4; ++r) { const float e = __expf(L[r * 512 + c] - mxc[r]); L[r * 512 + c] = e; sm[r] += e; } } }
#pragma unroll
        for (int r = 0; r < 4; ++r) inv[r] = 1.0f / fmaxf(wave_sum(sm[r]), 1e-30f);
        for (int c0 = 0; c0 < ncv; c0 += 64) { const int c = c0 + lane;
            if (c < ncv) {
#pragma unroll
                for (int r = 0; r < 4; ++r) L[r * 512 + c] *= inv[r]; } }
        WSYNC();
        for (int c = 0; c < ncv; ++c) { const float v = cv[(size_t)c * 128 + lane];
#pragma unroll
            for (int r = 0; r < 4; ++r) ocmp[r] += L[r * 512 + c] * v; }
    }
    const int NS = SAMPLE ? 33 : 128, cur = t >> 6;
    float sc0, sc1;
    {
        float s2[2];
#pragma unroll
        for (int q = 0; q < 2; ++q) {
            const int s = lane + 64 * q; float imp = 0.f;
            for (int c = 4 * s - 1; c <= 4 * s + 3; ++c) if (c >= 0 && c < ncv) imp += (L[c] + L[512 + c]) + (L[1024 + c] + L[1536 + c]);
            const bool forced = (s == 0) || (s == cur) || (s == cur - 1);
            float sc = (s <= cur) ? imp + (forced ? 1000.0f : 0.f) : -1e30f;
            if (s >= NS) sc = -3.0e38f;
            s2[q] = sc;
        }
        sc0 = s2[0]; sc1 = s2[1];
    }
    for (int k = 0; k < 16; ++k) {
        float best = sc0; int bi = lane;
        if (sc1 > best) { best = sc1; bi = lane + 64; }
#pragma unroll
        for (int o = 1; o < 64; o <<= 1) { const float ob = __shfl_xor(best, o); const int oi = __shfl_xor(bi, o); if (ob > best || (ob == best && oi < bi)) { best = ob; bi = oi; } }
        if (lane == 0) SEL[k] = bi;
        if (bi == lane) sc0 = -3.4e38f;
        if (bi == lane + 64) sc1 = -3.4e38f;
    }
    WSYNC();
    NsaSrc ssrc, wsrc;
    if (!SAMPLE) { ssrc.prow_base = ((float*)(F.ws + WS_P)) + (size_t)(bb * TP) * NINP + C_KVS + g * 64; wsrc.prow_base = ((float*)(F.ws + WS_P)) + (size_t)(bb * TP) * NINP + C_KVW + g * 64; ssrc.cache = wsrc.cache = nullptr; ssrc.pt = wsrc.pt = nullptr; ssrc.newtok = wsrc.newtok = nullptr; }
    else { ssrc.prow_base = wsrc.prow_base = nullptr; ssrc.cache = ((const float*)F.ka[5]) + (size_t)l * NPHYS * 128 * 256; wsrc.cache = ((const float*)F.ka[6]) + ((size_t)l * MS + bb) * 512 * 256; ssrc.pt = wsrc.pt = ((const int*)F.ka[8]) + bb * 16;
           ssrc.newtok = prow + C_KVS + g * 64; wsrc.newtok = prow + C_KVW + g * 64; }
    float oslc[4] = {0.f, 0.f, 0.f, 0.f}, owin[4] = {0.f, 0.f, 0.f, 0.f};
    {
        float mx[4] = {-INFINITY, -INFINITY, -INFINITY, -INFINITY}, ls[4] = {0.f, 0.f, 0.f, 0.f};
        for (int k = 0; k < 16; ++k) { const int s = SEL[k]; if (s > cur) continue; nsa_block<SAMPLE, false>(ssrc, 64 * s, t, g, lane, Q, PB, slope, mx, ls, oslc); }
#pragma unroll
        for (int r = 0; r < 4; ++r) oslc[r] /= fmaxf(ls[r], 1e-30f);
    }
    {
        float mx[4] = {-INFINITY, -INFINITY, -INFINITY, -INFINITY}, ls[4] = {0.f, 0.f, 0.f, 0.f};
        for (int j = 0; j < 8; ++j) { const int pos0 = t - 511 + 64 * j; if (pos0 + 63 < 0) continue; nsa_block<SAMPLE, true>(wsrc, pos0, t, g, lane, Q, PB, slope, mx, ls, owin); }
#pragma unroll
        for (int r = 0; r < 4; ++r) owin[r] /= fmaxf(ls[r], 1e-30f);
    }
#pragma unroll
    for (int r = 0; r < 4; ++r) ((bf16*)(F.ws + WS_O))[(size_t)m * D + (g * 4 + r) * 64 + lane] = (bf16)f2bf(gt[r][0] * ocmp[r] + gt[r][1] * oslc[r] + gt[r][2] * owin[r]);
}

namespace nsa {
using bf16x8 = __attribute__((ext_vector_type(8))) short;
using s16x4 = __attribute__((ext_vector_type(4))) short;
using f32x16 = __attribute__((ext_vector_type(16))) float;
using u32x4 = __attribute__((ext_vector_type(4))) unsigned;
typedef LAS const char* lds_cptr;
constexpr float LOG2E = 1.4426950408889634f, QSCALE = 0.125f * LOG2E, NEG = -1.0e30f, THR = 8.0f;
constexpr int L_K = 0, L_V = 16384, L_WSF = 32768, L_IMP = 36864, L_SELM = 102400, L_TL = 103424, L_END = 104448;
enum { M_CMP1 = 0, M_CMP2 = 1, M_SEL = 2, M_WIN = 3 };
__device__ __forceinline__ int crow(int r, int hi) { return (r & 3) + 8 * (r >> 2) + 4 * hi; }
__device__ __forceinline__ unsigned cvtpk(float lo, float hi) { unsigned r; asm volatile("v_cvt_pk_bf16_f32 %0, %1, %2" : "=v"(r) : "v"(lo), "v"(hi)); return r; }
__device__ __forceinline__ float halfmax(float m) { auto rr = __builtin_amdgcn_permlane32_swap(__float_as_uint(m), __float_as_uint(m), false, false); return fmaxf(__uint_as_float(rr[0]), __uint_as_float(rr[1])); }
__device__ __forceinline__ float halfsum(float m) { auto rr = __builtin_amdgcn_permlane32_swap(__float_as_uint(m), __float_as_uint(m), false, false); return __uint_as_float(rr[0]) + __uint_as_float(rr[1]); }
__device__ __forceinline__ void qkt(f32x16& p0, f32x16& p1, lds_cptr kslot, const bf16x8* qr, int r32, int hi) {
    lds_cptr kb = kslot + hi * 1024 + r32 * 16;
    p0 = f32x16{}; p1 = f32x16{};
#pragma unroll
    for (int d0 = 0; d0 < 4; ++d0) {
        const bf16x8 b0 = *(const LAS bf16x8*)(kb + d0 * 2048), b1 = *(const LAS bf16x8*)(kb + d0 * 2048 + 512);
        p0 = __builtin_amdgcn_mfma_f32_32x32x16_bf16(b0, qr[d0], p0, 0, 0, 0); p1 = __builtin_amdgcn_mfma_f32_32x32x16_bf16(b1, qr[d0], p1, 0, 0, 0);
    }
}
__device__ __forceinline__ void pv(f32x16* o, int vb, bf16x8 pa0, bf16x8 pa1, bf16x8 pa2, bf16x8 pa3) {
#pragma unroll
    for (int d0 = 0; d0 < 2; ++d0) { s16x4 lo[4], hi[4];
#pragma unroll
        for (int ks = 0; ks < 4; ++ks) {
            asm volatile("ds_read_b64_tr_b16 %0,%1 offset:%c2" : "=&v"(lo[ks]) : "v"(vb), "i"(d0 * 4096 + ks * 1024) : "memory");
            asm volatile("ds_read_b64_tr_b16 %0,%1 offset:%c2" : "=&v"(hi[ks]) : "v"(vb), "i"(d0 * 4096 + ks * 1024 + 512) : "memory"); }
        asm volatile("s_waitcnt lgkmcnt(0)" ::: "memory"); __builtin_amdgcn_sched_barrier(0);
#define NSA_PK(k) (bf16x8){lo[k][0], lo[k][1], lo[k][2], lo[k][3], hi[k][0], hi[k][1], hi[k][2], hi[k][3]}
        o[d0] = __builtin_amdgcn_mfma_f32_32x32x16_bf16(pa0, NSA_PK(0), o[d0], 0, 0, 0);
        o[d0] = __builtin_amdgcn_mfma_f32_32x32x16_bf16(pa1, NSA_PK(1), o[d0], 0, 0, 0);
        o[d0] = __builtin_amdgcn_mfma_f32_32x32x16_bf16(pa2, NSA_PK(2), o[d0], 0, 0, 0);
        o[d0] = __builtin_amdgcn_mfma_f32_32x32x16_bf16(pa3, NSA_PK(3), o[d0], 0, 0, 0);
#undef NSA_PK
    }
}
struct Ctx {
    LAS char* shm; LAS float* wsf; LAS float* impG; LAS float* impT; LAS unsigned* selm; LAS int* tl;
    const bf16* ckb; const bf16* cvb; const bf16* kvs; const bf16* kvw;
    int lane, wid, r32, hi, qb, tq; float sl2;
};
template <int MODE> __device__ __forceinline__ int tile_idx(const Ctx& c, int i) { return (MODE == M_SEL) ? c.tl[1 + i] : ((MODE == M_WIN) ? c.qb - i : i); }
template <int MODE> __device__ __forceinline__ void stage_issue(const Ctx& c, int tile, u32x4& kreg, u32x4& vreg) {
    if (MODE == M_CMP1 || MODE == M_CMP2) {
        int kr = 64 * tile + c.lane; kr = kr > 511 ? 511 : kr;
        kreg = *(const u32x4*)(c.ckb + (size_t)kr * 128 + c.wid * 8);
        if (MODE == M_CMP2) { int vr = 64 * tile + 16 * (c.wid & 3) + (c.lane >> 2); vr = vr > 511 ? 511 : vr; vreg = *(const u32x4*)(c.cvb + (size_t)vr * 128 + (c.wid >> 2) * 32 + (c.lane & 3) * 8); }
    } else {
        const bf16* base = (MODE == M_SEL ? c.kvs : c.kvw) + (size_t)(64 * tile) * 256;
        kreg = *(const u32x4*)(base + (size_t)c.lane * 256 + c.wid * 8);
        vreg = *(const u32x4*)(base + 128 + (size_t)(16 * (c.wid & 3) + (c.lane >> 2)) * 256 + (c.wid >> 2) * 32 + (c.lane & 3) * 8);
    }
}
template <int MODE> __device__ __forceinline__ void stage_write(const Ctx& c, int slot, const u32x4& kreg, const u32x4& vreg) {
    *(LAS u32x4*)(c.shm + L_K + slot * 8192 + c.wid * 1024 + c.lane * 16) = kreg;
    if (MODE != M_CMP1) *(LAS u32x4*)(c.shm + L_V + slot * 8192 + c.wid * 1024 + c.lane * 16) = vreg;
}
template <int MODE> __device__ __forceinline__ void run_tiles(const Ctx& c_in, int ntiles, const bf16* qp_in, float& m, float& l, float invl, f32x16* o) {
    Ctx c = c_in;
    { int ln = c.lane; asm volatile("" : "+v"(ln)); c.lane = ln; c.r32 = ln & 31; c.hi = ln >> 5; }
    const int lane = c.lane, r32 = c.r32, hi = c.hi;
    const int vb0 = (int)(unsigned)(uintptr_t)(c.shm + L_V) + ((lane >> 4) & 1) * 32 + (lane & 3) * 8 + (4 * hi + ((lane & 15) >> 2)) * 64;
    const float kst = (MODE == M_CMP1 || MODE == M_CMP2) ? 16.0f * c.sl2 : c.sl2;
    const float kst4hi = kst * (float)(4 * hi);
    bf16x8 qr[4];
    { const bf16* qp = qp_in + hi * 8;
#pragma unroll
      for (int d0 = 0; d0 < 4; ++d0) qr[d0] = *(const bf16x8*)(qp + d0 * 16); }
    u32x4 kreg, vreg;
    __syncthreads();
    stage_issue<MODE>(c, tile_idx<MODE>(c, 0), kreg, vreg);
    stage_write<MODE>(c, 0, kreg, vreg);
    __syncthreads();
    if (ntiles > 1) stage_issue<MODE>(c, tile_idx<MODE>(c, 1), kreg, vreg);
    float tcarry = 0.f;
    for (int i = 0; i < ntiles; ++i) {
        const int tile = tile_idx<MODE>(c, i), slot = i & 1;
        f32x16 p0, p1;
        qkt(p0, p1, (lds_cptr)(c.shm + L_K + slot * 8192), qr, r32, hi);
        int lim, lo = -100000; bool rowsel = true; float base;
        if (MODE == M_CMP1 || MODE == M_CMP2) { base = c.sl2 * (float)(1024 * tile + 31 - c.tq); lim = (c.tq >= 31 ? ((c.tq - 31) >> 4) : -1) - 64 * tile; }
        else { base = c.sl2 * (float)(64 * tile - c.tq); lim = c.tq - 64 * tile; if (MODE == M_WIN) lo = lim - 511;
               if (MODE == M_SEL) rowsel = (c.selm[(c.wid * 8 + (r32 >> 2)) * 4 + (tile >> 5)] >> (tile & 31)) & 1u; }
        base += kst4hi;
        const float base1 = base + 32.0f * kst;
        const bool full = rowsel && lim >= 63 && lo <= 0;
#pragma unroll
        for (int r = 0; r < 16; ++r) { const float kf = (float)((r & 3) + 8 * (r >> 2)); p0[r] = fmaf(kst, kf, p0[r] + base); p1[r] = fmaf(kst, kf, p1[r] + base1); }
        if (!__all(full)) {
            const int lim0 = rowsel ? lim - 4 * hi : -1000, lo0 = lo - 4 * hi;
#pragma unroll
            for (int r = 0; r < 16; ++r) { const int kk = (r & 3) + 8 * (r >> 2);
                p0[r] = (kk <= lim0 && kk >= lo0) ? p0[r] : NEG;
                p1[r] = (kk + 32 <= lim0 && kk + 32 >= lo0) ? p1[r] : NEG; }
        }
        if (MODE != M_CMP2) {
            float rm = p0[0];
#pragma unroll
            for (int r = 1; r < 16; ++r) rm = fmaxf(rm, p0[r]);
#pragma unroll
            for (int r = 0; r < 16; ++r) rm = fmaxf(rm, p1[r]);
            rm = halfmax(rm);
            if (MODE == M_CMP1) { const float mn = fmaxf(m, rm); l *= __builtin_amdgcn_exp2f(m - mn); m = mn; }
            else if (__any(rm > m + THR)) {
                const float mn = fmaxf(m, rm), f = __builtin_amdgcn_exp2f(m - mn); m = mn; l *= f;
                if (hi == 0) c.wsf[r32] = f;
                WSYNC();
#pragma unroll
                for (int r = 0; r < 16; ++r) { const float fr = c.wsf[crow(r, hi)]; o[0][r] *= fr; o[1][r] *= fr; }
                WSYNC();
            }
        }
        float sacc = 0.f;
#pragma unroll
        for (int r = 0; r < 16; ++r) { p0[r] = __builtin_amdgcn_exp2f(p0[r] - m); p1[r] = __builtin_amdgcn_exp2f(p1[r] - m); sacc += p0[r] + p1[r]; }
        if (MODE != M_CMP2) l += sacc;
        if (MODE == M_CMP2) {
#pragma unroll
            for (int r = 0; r < 16; ++r) { p0[r] *= invl; p1[r] *= invl; }
            float Gs[8], Ts[8];
#pragma unroll
            for (int k = 0; k < 4; ++k) { Gs[k] = (p0[4 * k] + p0[4 * k + 1]) + (p0[4 * k + 2] + p0[4 * k + 3]); Ts[k] = p0[4 * k + 3];
                                          Gs[4 + k] = (p1[4 * k] + p1[4 * k + 1]) + (p1[4 * k + 2] + p1[4 * k + 3]); Ts[4 + k] = p1[4 * k + 3]; }
#pragma unroll
            for (int k = 0; k < 8; ++k) { Gs[k] += __shfl_xor(Gs[k], 1); Gs[k] += __shfl_xor(Gs[k], 2); Ts[k] += __shfl_xor(Ts[k], 1); Ts[k] += __shfl_xor(Ts[k], 2); }
            if ((r32 & 3) == 0) { const int qi = r32 >> 2;
#pragma unroll
                for (int k = 0; k < 8; ++k) { const int s = 16 * tile + 2 * (k & 3) + hi + 8 * (k >> 2); c.impG[qi * 128 + s] = Gs[k]; c.impT[qi * 128 + s] = Ts[k]; } }
            (void)tcarry;
        }
        if (MODE != M_CMP1) {
            u32x4 pw0, pw1, pw2, pw3;
            pw0 = (u32x4){cvtpk(p0[0], p0[1]), cvtpk(p0[2], p0[3]), cvtpk(p0[4], p0[5]), cvtpk(p0[6], p0[7])};
            pw1 = (u32x4){cvtpk(p0[8], p0[9]), cvtpk(p0[10], p0[11]), cvtpk(p0[12], p0[13]), cvtpk(p0[14], p0[15])};
            pw2 = (u32x4){cvtpk(p1[0], p1[1]), cvtpk(p1[2], p1[3]), cvtpk(p1[4], p1[5]), cvtpk(p1[6], p1[7])};
            pw3 = (u32x4){cvtpk(p1[8], p1[9]), cvtpk(p1[10], p1[11]), cvtpk(p1[12], p1[13]), cvtpk(p1[14], p1[15])};
            __builtin_amdgcn_sched_barrier(0);
            pv(o, vb0 + slot * 8192, __builtin_bit_cast(bf16x8, pw0), __builtin_bit_cast(bf16x8, pw1), __builtin_bit_cast(bf16x8, pw2), __builtin_bit_cast(bf16x8, pw3));
        }
        if (i + 1 < ntiles) stage_write<MODE>(c, slot ^ 1, kreg, vreg);
        __syncthreads();
        if (i + 2 < ntiles) stage_issue<MODE>(c, tile_idx<MODE>(c, i + 2), kreg, vreg);
    }
}

__device__ __forceinline__ void unit(Frame& F, int l, int b, int g, int qb) {
    Ctx c;
    c.shm = (LAS char*)F.lds; c.lane = F.lane; c.wid = F.wave; c.r32 = F.lane & 31; c.hi = F.lane >> 5; c.qb = qb;
    c.wsf = (LAS float*)(c.shm + L_WSF) + c.wid * 128;
    c.impG = (LAS float*)(c.shm + L_IMP + c.wid * 8192); c.impT = c.impG + 1024;
    c.selm = (LAS unsigned*)(c.shm + L_SELM); c.tl = (LAS int*)(c.shm + L_TL);
    const int r32 = c.r32, hi = c.hi, hh = r32 & 3, head = g * 4 + hh;
    c.tq = qb * 64 + c.wid * 8 + (r32 >> 2);
    const size_t tok = (size_t)b * TP + c.tq;
    c.sl2 = exp2f(-(float)(head + 1)) * LOG2E;
    c.ckb = (const bf16*)(F.ws + WS_CKB) + ((size_t)(0 * 2 + b) * 512) * 128 + g * 64;
    c.cvb = (const bf16*)(F.ws + WS_CKB) + ((size_t)(1 * 2 + b) * 512) * 128 + g * 64;
    c.kvs = (const bf16*)(F.ws + WS_KVS) + ((size_t)b * TP) * 256 + g * 64;
    c.kvw = (const bf16*)(F.ws + WS_KVW) + ((size_t)b * TP) * 256 + g * 64;
    const bf16* qr = (const bf16*)(F.ws + WS_QB) + tok * 512 + head * 64;
    LAS float* ost = (LAS float*)(c.shm + L_IMP + c.wid * 8192);
    const float* gp = (const float*)(F.ws + WS_P) + tok * NINP + C_GN + head * 3;
    const float g0 = sigmoidf_(gp[0]), g1 = sigmoidf_(gp[1]), g2 = sigmoidf_(gp[2]);
    for (int i = c.lane; i < 2048; i += 64) c.impG[i] = 0.f;
    WSYNC();
    f32x16 ocmp0, ocmp1;
    {
        const int nct = ((4 * qb + 2) >> 6) + 1;
        float m = NEG, lsum = 0.f; f32x16 o[2]; o[0] = f32x16{}; o[1] = f32x16{};
        run_tiles<M_CMP1>(c, nct, qr, m, lsum, 0.f, o);
        lsum = halfsum(lsum);
        const float invl = (m > -1.0e29f) ? 1.0f / fmaxf(lsum, 1e-30f) : 0.f;
        if (!(m > -1.0e29f)) m = 0.f;
        run_tiles<M_CMP2>(c, nct, qr, m, lsum, invl, o);
        ocmp0 = o[0]; ocmp1 = o[1];
    }
    {
        const int qi = c.lane >> 3, j = c.lane & 7;
        float sc[16];
#pragma unroll
        for (int i = 0; i < 16; ++i) { const int s = j + 8 * i; const float imp = c.impG[qi * 128 + s] + (s > 0 ? c.impT[qi * 128 + s - 1] : 0.f);
            const bool forced = (s == 0) || (s == qb) || (s == qb - 1);
            sc[i] = (s <= qb) ? imp + (forced ? 1000.0f : 0.f) : -1.0e30f; }
        unsigned mw0 = 0u, mw1 = 0u, mw2 = 0u, mw3 = 0u;
        for (int k = 0; k < 16; ++k) {
            float best = sc[0]; int bi = j;
#pragma unroll
            for (int i = 1; i < 16; ++i) if (sc[i] > best) { best = sc[i]; bi = j + 8 * i; }
#pragma unroll
            for (int x = 1; x < 8; x <<= 1) { const float ob = __shfl_xor(best, x); const int oi = __shfl_xor(bi, x); if (ob > best || (ob == best && oi < bi)) { best = ob; bi = oi; } }
#pragma unroll
            for (int i = 0; i < 16; ++i) if (bi == j + 8 * i) sc[i] = -3.4e38f;
            const unsigned bit = 1u << (bi & 31); const int w = bi >> 5;
            mw0 |= (w == 0) ? bit : 0u; mw1 |= (w == 1) ? bit : 0u; mw2 |= (w == 2) ? bit : 0u; mw3 |= (w == 3) ? bit : 0u;
        }
        if (j == 0) { LAS unsigned* sm = c.selm + (c.wid * 8 + qi) * 4; sm[0] = mw0; sm[1] = mw1; sm[2] = mw2; sm[3] = mw3; }
    }
    WSYNC();
    {
        if (hi == 0) c.wsf[64 + r32] = g0;
        WSYNC();
#pragma unroll
        for (int r = 0; r < 16; ++r) { const float cf = c.wsf[64 + crow(r, hi)]; const int orow = crow(r, hi); ost[orow * 64 + r32] = ocmp0[r] * cf; ost[orow * 64 + 32 + r32] = ocmp1[r] * cf; }
        WSYNC();
    }
    __syncthreads();
    if (F.tid < 64) {
        unsigned u0 = c.selm[F.tid * 4 + 0], u1 = c.selm[F.tid * 4 + 1], u2 = c.selm[F.tid * 4 + 2], u3 = c.selm[F.tid * 4 + 3];
#pragma unroll
        for (int x = 1; x < 64; x <<= 1) { u0 |= __shfl_xor(u0, x); u1 |= __shfl_xor(u1, x); u2 |= __shfl_xor(u2, x); u3 |= __shfl_xor(u3, x); }
        if (F.tid == 0) { int n = 0;
            for (int s = qb; s >= 0; --s) { const unsigned wv = (s >> 5) == 0 ? u0 : ((s >> 5) == 1 ? u1 : ((s >> 5) == 2 ? u2 : u3)); if ((wv >> (s & 31)) & 1u) { c.tl[1 + n] = s; ++n; } }
            c.tl[0] = n; }
    }
    __syncthreads();
    {
        const int nt = c.tl[0];
        float m = NEG, lsum = 0.f; f32x16 o[2]; o[0] = f32x16{}; o[1] = f32x16{};
        run_tiles<M_SEL>(c, nt, qr, m, lsum, 0.f, o);
        lsum = halfsum(lsum);
        const float cf0 = (m > -1.0e29f) ? g1 / fmaxf(lsum, 1e-30f) : 0.f;
        if (hi == 0) c.wsf[64 + r32] = cf0;
        WSYNC();
#pragma unroll
        for (int r = 0; r < 16; ++r) { const float cf = c.wsf[64 + crow(r, hi)]; const int orow = crow(r, hi); ost[orow * 64 + r32] += o[0][r] * cf; ost[orow * 64 + 32 + r32] += o[1][r] * cf; }
        WSYNC();
    }
    {
        const int nt = qb + 1 < 9 ? qb + 1 : 9;
        float m = NEG, lsum = 0.f; f32x16 o[2]; o[0] = f32x16{}; o[1] = f32x16{};
        run_tiles<M_WIN>(c, nt, qr, m, lsum, 0.f, o);
        lsum = halfsum(lsum);
        const float cf0 = (m > -1.0e29f) ? g2 / fmaxf(lsum, 1e-30f) : 0.f;
        if (hi == 0) c.wsf[64 + r32] = cf0;
        WSYNC();
#pragma unroll
        for (int r = 0; r < 16; ++r) { const float cf = c.wsf[64 + crow(r, hi)]; const int orow = crow(r, hi); ost[orow * 64 + r32] += o[0][r] * cf; ost[orow * 64 + 32 + r32] += o[1][r] * cf; }
        WSYNC();
    }
    {
        bf16* Ob = (bf16*)(F.ws + WS_O);
#pragma unroll
        for (int i = 0; i < 4; ++i) { const int row = i * 8 + (c.lane >> 3), ch = c.lane & 7;
            const f32x4 a = *(const LAS f32x4*)(ost + row * 64 + ch * 8), bq = *(const LAS f32x4*)(ost + row * 64 + ch * 8 + 4);
            u32x4 v; v.x = pk2(a.x, a.y); v.y = pk2(a.z, a.w); v.z = pk2(bq.x, bq.y); v.w = pk2(bq.z, bq.w);
            *(u32x4*)(Ob + ((size_t)b * TP + qb * 64 + c.wid * 8 + (row >> 2)) * D + (g * 4 + (row & 3)) * 64 + ch * 8) = v; }
        WSYNC();
    }
    __syncthreads();
}
}
__device__ __forceinline__ void nsa_prompt_phase(Frame& F, int l) {
    for (int u = F.bx; u < 512; u += F.G) { const int bg = (u & 255) >> 6, s = u & 63, qb = (u < 256) ? s : 127 - s; nsa::unit(F, l, bg >> 1, bg & 1, qb); }
}

__device__ __forceinline__ void att_phase(Frame& F, int l) {
    gla_scan_phase(F, l);
    LAS unsigned char* wl = F.lds + F.wave * NSA_WAVE_BYTES;
    for (int task = F.gw; task < 256; task += F.NGW) nsa_task<true>(F, l, task, wl);
    __syncthreads();
    nsa_prompt_phase(F, l);
}
__global__ void __launch_bounds__(NTHR, 2) fwd_kernel(Args args) {
    extern __shared__ __attribute__((aligned(16))) unsigned char lds_raw[];
    Frame F;
    F.lds = (LAS unsigned char*)lds_raw;
    F.MISC = (volatile LAS unsigned*)(F.lds + MISC_OFF);
    F.tid = threadIdx.x; F.lane = F.tid & 63; F.wave = __builtin_amdgcn_readfirstlane(F.tid >> 6);
    F.G = gridDim.x; F.bx = blockIdx.x; F.gw = F.bx * NWAVES + F.wave; F.NGW = F.G * NWAVES;
    unsigned char* ws = args.ws; F.ws = ws; F.out = args.out;
    F.ctl = (gu32*)(ws + WS_CTL);
    F.ka = (KArgPtr)__builtin_amdgcn_kernarg_segment_ptr();
    for (int u = F.tid; u < (LDS_BYTES - RING_BYTES) / 4; u += NTHR) ((LAS unsigned*)(F.lds + RING_BYTES))[u] = 0u;
    __syncthreads();
    XcdBarrier bar = xcd_barrier_post((unsigned*)(F.ctl + CW_BAR), F.MISC + 8);
    const int lo = args.ph_lo, hi = args.ph_hi;
#define IN(k) (lo <= (k) && (k) < hi)
#define SEAM(k) do { if (IN(k) && IN((k) + 1)) xcd_barrier(bar); } while (0)

    if (IN(0)) { p0_prologue(F); } SEAM(0);
    for (int seg = 0; seg < 4; ++seg) {
        const int l = seg >> 1, second = seg & 1, pb = 1 + 12 * l + (second ? 9 : 0);
        {
            int t_ = threadIdx.x; asm volatile("" : "+v"(t_)); F.tid = t_; F.lane = t_ & 63; F.wave = __builtin_amdgcn_readfirstlane(t_ >> 6);
            unsigned char* w_ = args.ws; asm volatile("" : "+s"(w_)); F.ws = w_; ws = w_; F.ctl = (gu32*)(w_ + WS_CTL);
            float* o_ = args.out; asm volatile("" : "+s"(o_)); F.out = o_;
            int b_ = blockIdx.x; asm volatile("" : "+s"(b_)); F.bx = b_; F.gw = b_ * NWAVES + F.wave;
        }
        unsigned char* wl = ws + WS_W + (size_t)l * WL_STRIDE;
        const float* modl = ((float*)(F.ws + WS_MOD)) + (size_t)l * NMODROWS * MODW;
        if (IN(pb)) { norm_phase(F, l, second ? 2 : 0); } SEAM(pb);
        if (IN(pb + 1)) {
            pg8::Gemm g{((bf16*)(F.ws + WS_HN)), (const bf16*)(wl + (second ? WO_W3 : WO_W1)), MPAD, 2 * FF, D}; pg8::StaticOrder S; S.init(MPAD, 2 * FF, F.G, F.bx);
            EpiSwiGLU E{((bf16*)(F.ws + WS_HF))};
            pg8::gemm_phase<EpiSwiGLU, pg8::StaticOrder, true, true>(F.lds, g, S, E);
        } SEAM(pb + 1);
        if (IN(pb + 2)) {
            pg8::Gemm g{((bf16*)(F.ws + WS_HF)), (const bf16*)(wl + (second ? WO_W4 : WO_W2)), MPAD, D, FF}; pg8::StaticOrder S; S.init(MPAD, D, F.G, F.bx);
            EpiResid E{((float*)(F.ws + WS_X)), modl, (second ? 8 : 2) * D, 0.5f};
            pg8::gemm_phase<EpiResid, pg8::StaticOrder, true, true>(F.lds, g, S, E);
        } SEAM(pb + 2);
        if (!second) {
            if (IN(pb + 3)) { norm_phase(F, l, 1); } SEAM(pb + 3);
            if (IN(pb + 4)) {
                pg8::Gemm g{((bf16*)(F.ws + WS_HN)), (const bf16*)(wl + WO_WIN), MPAD, NINP, D}; pg8::StaticOrder S; S.init(MPAD, NINP, F.G, F.bx);
                EpiF32 E{((float*)(F.ws + WS_P)), NINP};
                pg8::gemm_phase<EpiF32, pg8::StaticOrder, true, true>(F.lds, g, S, E);
            } SEAM(pb + 4);
            if (IN(pb + 5)) { kv_out_phase(F, l); compress_phase(F, l); gla_g1_phase(F, l); gla_sample_phase(F, l); } SEAM(pb + 5);
            if (IN(pb + 6)) { att_phase(F, l); } SEAM(pb + 6);
            if (IN(pb + 7)) { gla_g3_phase(F, l); } SEAM(pb + 7);
            if (IN(pb + 8)) {
                pg8::Gemm g{((bf16*)(F.ws + WS_O)), (const bf16*)(wl + WO_WO), MPAD, D, D}; pg8::StaticOrder S; S.init(MPAD, D, F.G, F.bx);
                EpiResid E{((float*)(F.ws + WS_X)), modl, 5 * D, 1.0f};
                pg8::gemm_phase<EpiResid, pg8::StaticOrder, true, true>(F.lds, g, S, E);
            } SEAM(pb + 8);
        }
    }
    if (IN(25)) { final_norm_phase(F); }
#undef IN
#undef SEAM
}

extern "C" void kernel_launch(void* const* d_in, const int* in_sizes, int n_in, void* d_out, int out_size, void* d_ws, size_t ws_size, hipStream_t stream) {
    static int grid = 0;
    if (grid == 0) {
        if (n_in != 26 || out_size != (int)O_END || ws_size < WS_END) { fprintf(stderr, "kernel_launch: unexpected shapes: n_in %d out %d ws %zu\n", n_in, out_size, ws_size); grid = -1; return; }
        int dev = 0, cus = 0;
        if (hipGetDevice(&dev) != hipSuccess || hipDeviceGetAttribute(&cus, hipDeviceAttributeMultiprocessorCount, dev) != hipSuccess) { grid = -1; return; }
        if (hipFuncSetAttribute((const void*)fwd_kernel, hipFuncAttributeMaxDynamicSharedMemorySize, LDS_BYTES) != hipSuccess) { fprintf(stderr, "kernel_launch: hipFuncSetAttribute failed\n"); grid = -1; return; }
        int per_cu = 0;
        if (hipOccupancyMaxActiveBlocksPerMultiprocessor(&per_cu, (const void*)fwd_kernel, NTHR, LDS_BYTES) != hipSuccess || per_cu < 1) fprintf(stderr, "kernel_launch: occupancy query reports %d\n", per_cu);
        (void)hipGetLastError();
        grid = cus;
    }
    if (grid < 0) return;
    if (hipMemsetAsync((char*)d_ws + WS_CTL, 0, CTL_ZERO_BYTES, stream) != hipSuccess) return;
    Args a{};
    for (int i = 0; i < 26; ++i) a.in[i] = d_in[i];
    a.out = (float*)d_out; a.ws = (unsigned char*)d_ws;
#if MK_SINGLE
    a.ph_lo = 0; a.ph_hi = NPHASES;
    hipLaunchKernelGGL(fwd_kernel, dim3(grid), dim3(NTHR), LDS_BYTES, stream, a);
#else
    for (int ph = 0; ph < NPHASES; ++ph) { a.ph_lo = ph; a.ph_hi = ph + 1; hipLaunchKernelGGL(fwd_kernel, dim3(grid), dim3(NTHR), LDS_BYTES, stream, a); }
#endif
}
```
